# Optimizing an MI355X kernel written in HIP

```python
import math
import jax, jax.numpy as jnp
from jax import lax
import numpy as np

D_MODEL = 1024
BATCH = 4
SEQ = 8192
DEPTH = 1
DEC_BATCH = 32
DEC_SEQ = 8
PAST_LEN = 16384
PAGE_SIZE = 128

HEAD_DIM = 64
D_MIX = D_MODEL
D_A = D_MIX // 2
D_B = D_MIX - D_A
A_GROUPS = D_A // HEAD_DIM
CHUNK = 128
N_HEADS = D_B // HEAD_DIM
N_KV = 2
GQA = N_HEADS // N_KV
KV_W = N_KV * HEAD_DIM
CMP_STRIDE = 16
CMP_BLOCK = 32
CMP_R = CMP_BLOCK // CMP_STRIDE
CMP_HIDDEN = 256
SEL_BLOCK = 64
N_SEL = 16
WINDOW = 512
N_BUCKETS = 32
MAX_DISTANCE = 128
Q_BLOCK = 128
IN_SIZES = (D_A, D_A, D_A, D_B, 2 * KV_W, 2 * KV_W, 2 * KV_W, 3 * N_HEADS, D_B)
D_IN = sum(IN_SIZES)
RMS_EPS = 1e-6
LN_EPS = 1e-5
NEG = -1e30
FORCE_BONUS = 1e6

kernel_name = 'hymba_gmlp_nsa_decode_step'


def rmsnorm(x, g):
    xf = x.astype(jnp.float32)
    y = xf * lax.rsqrt(jnp.mean(xf * xf, axis=-1, keepdims=True) + RMS_EPS)
    return (y * g.astype(jnp.float32)).astype(x.dtype)


def t5_bucket(dist):
    n = jnp.maximum(dist, 0)
    max_exact = N_BUCKETS // 2
    nf = jnp.maximum(n, max_exact).astype(jnp.float32)
    large = max_exact + (jnp.log(nf / max_exact) / math.log(MAX_DISTANCE / max_exact)
                         * (N_BUCKETS - max_exact)).astype(jnp.int32)
    return jnp.where(n < max_exact, n, jnp.minimum(large, N_BUCKETS - 1))


def bias_qk(rel_table, dist):
    b = rel_table.astype(jnp.float32)[t5_bucket(dist)]
    return b.reshape(dist.shape + (N_KV, GQA)).transpose(0, 2, 3, 1)


def split_proj(x, norm_g, w_in):
    h = rmsnorm(x, norm_g)
    p = jnp.einsum('bsd,de->bse', h, w_in)
    offs = np.cumsum(IN_SIZES)[:-1].tolist()
    u, v, z_a, q, kv_c, kv_s, kv_w, g, z_b = jnp.split(p, offs, axis=-1)
    B, S = x.shape[:2]
    kv = (B, S, 2, N_KV, HEAD_DIM)
    q = q.astype(jnp.float32).reshape(B, S, N_KV, GQA, HEAD_DIM)
    gates = jax.nn.sigmoid(g.astype(jnp.float32)).reshape(B, S, N_KV, GQA, 3)
    return u, v, z_a, q, kv_c.reshape(kv), kv_s.reshape(kv), kv_w.reshape(kv), gates, z_b


def chunk_mlp_prep(u, v, ln_g):
    B, S = u.shape[:2]
    u = jax.nn.gelu(u.astype(jnp.float32)).reshape(B, S, A_GROUPS, HEAD_DIM)
    v = jax.nn.gelu(v.astype(jnp.float32)).reshape(B, S, A_GROUPS, HEAD_DIM)
    mu = jnp.mean(v, axis=-1, keepdims=True)
    var = jnp.mean(jnp.square(v - mu), axis=-1, keepdims=True)
    v = (v - mu) * lax.rsqrt(var + LN_EPS) * ln_g.astype(jnp.float32).reshape(A_GROUPS, HEAD_DIM)
    return u, v


def spatial_gate(u, v, w_s, b_s):
    n = v.shape[2]
    w = jnp.tril(w_s[:, :n, :n].astype(jnp.float32))
    s = jnp.einsum('gts,bcsgd->bctgd', w, v) + b_s[:, :n].astype(jnp.float32).T[None, None, :, :, None]
    return u * s


def compress_blocks(k, pe, w1, b1, w2, b2):
    B, T, G, dh = k.shape
    n_chunks = T // CMP_STRIDE
    nc = n_chunks - CMP_R + 1
    ch = k[:, :n_chunks * CMP_STRIDE].astype(jnp.float32).reshape(B, n_chunks, CMP_STRIDE, G, dh)
    pe = pe.astype(jnp.float32).reshape(CMP_R, CMP_STRIDE, dh)
    w1 = w1.astype(jnp.float32)
    h = b1.astype(jnp.float32)
    for s in range(CMP_R):
        proj = jnp.einsum('bnlgd,ldh->bngh', ch, w1[s])
        h = h + proj[:, s:s + nc] + jnp.einsum('ld,ldh->h', pe[s], w1[s])
    return jnp.einsum('bngh,hd->bngd', jax.nn.gelu(h), w2.astype(jnp.float32)) + b2.astype(jnp.float32)


def compress_kv(kv, pe, w1, b1, w2, b2):
    kc = compress_blocks(kv[:, :, 0], pe[0], w1[0], b1[0], w2[0], b2[0])
    vc = compress_blocks(kv[:, :, 1], pe[1], w1[1], b1[1], w2[1], b2[1])
    return kc, vc


def sel_blocks(kv):
    B, T = kv.shape[:2]
    ns = -(-T // SEL_BLOCK)
    kv = jnp.pad(kv.astype(jnp.float32), ((0, 0), (0, ns * SEL_BLOCK - T), (0, 0), (0, 0), (0, 0)))
    blk = kv.reshape(B, ns, SEL_BLOCK, 2, N_KV, HEAD_DIM).transpose(3, 0, 4, 1, 2, 5)
    return blk[0], blk[1]


def _cover_matrix(nc, ns):
    c0 = np.arange(nc) * CMP_STRIDE
    s0 = np.arange(ns) * SEL_BLOCK
    m = (c0[:, None] < s0[None, :] + SEL_BLOCK) & (c0[:, None] + CMP_BLOCK > s0[None, :])
    return m.astype(np.float32)


def nsa_attend(q, q_pos, gates, kc, vc, ks_blk, vs_blk, kw, vw, w_pos, rel_table):
    scale = HEAD_DIM ** -0.5
    B = q.shape[0]
    qp = q_pos[:, None]
    nc = kc.shape[1]
    c_end = jnp.arange(nc, dtype=jnp.int32) * CMP_STRIDE + (CMP_BLOCK - 1)
    c_mask = (c_end[None, :] <= qp)[:, None, None, :]
    s_c = jnp.einsum('bqgrd,bcgd->bqgrc', q, kc) * scale + bias_qk(rel_table, qp - c_end[None, :])
    p_c = jax.nn.softmax(jnp.where(c_mask, s_c, NEG), axis=-1) * c_mask
    o_c = jnp.einsum('bqgrc,bcgd->bqgrd', p_c, vc)
    ns = ks_blk.shape[2]
    imp = jnp.einsum('bqgc,cs->bqgs', p_c.sum(axis=3), jnp.asarray(_cover_matrix(nc, ns)))
    blk = jnp.arange(ns, dtype=jnp.int32)[None, :]
    cur = (q_pos // SEL_BLOCK)[:, None]
    forced = (blk == 0) | (blk == cur) | (blk == cur - 1)
    imp = imp + jnp.where(forced, FORCE_BONUS, 0.0)[:, None, :]
    imp = jnp.where((blk * SEL_BLOCK <= qp)[:, None, :], imp, NEG)
    top_v, top_i = lax.top_k(imp, min(N_SEL, ns))
    b_idx = jnp.arange(B)[:, None, None, None]
    g_idx = jnp.arange(N_KV)[None, None, :, None]
    ks = ks_blk[b_idx, g_idx, top_i]
    vs = vs_blk[b_idx, g_idx, top_i]
    s_pos = top_i[..., None] * SEL_BLOCK + jnp.arange(SEL_BLOCK, dtype=jnp.int32)
    s_mask = (s_pos <= q_pos[None, :, None, None, None]) & (top_v > NEG / 2)[..., None]
    tbl = rel_table.astype(jnp.float32).reshape(N_BUCKETS, N_KV, GQA).transpose(1, 0, 2)
    s_bias = tbl[g_idx[..., None], t5_bucket(q_pos[None, :, None, None, None] - s_pos)]
    s_bias = s_bias.transpose(0, 1, 2, 5, 3, 4)
    s_s = jnp.einsum('bqgrd,bqgnkd->bqgrnk', q, ks) * scale + s_bias
    s_s = jnp.where(s_mask[:, :, :, None], s_s, NEG)
    sh = s_s.shape
    p_s = jax.nn.softmax(s_s.reshape(sh[:4] + (-1,)), axis=-1).reshape(sh)
    o_s = jnp.einsum('bqgrnk,bqgnkd->bqgrd', p_s, vs)
    dist_w = qp - w_pos[None, :]
    w_mask = ((dist_w >= 0) & (dist_w < WINDOW) & (w_pos[None, :] >= 0))[:, None, None, :]
    s_w = jnp.einsum('bqgrd,bkgd->bqgrk', q, kw) * scale + bias_qk(rel_table, dist_w)
    p_w = jax.nn.softmax(jnp.where(w_mask, s_w, NEG), axis=-1)
    o_w = jnp.einsum('bqgrk,bkgd->bqgrd', p_w, vw)
    o = gates[..., 0:1] * o_c + gates[..., 1:2] * o_s + gates[..., 2:3] * o_w
    return o.reshape(B, q.shape[1], D_B)


def nsa_prompt(q, gates, kc, vc, ks_blk, vs_blk, kv_w, rel_table):
    B, S = q.shape[:2]
    kw_pad = jnp.pad(kv_w.astype(jnp.float32), ((0, 0), (WINDOW, 0), (0, 0), (0, 0), (0, 0)))

    def block(i):
        q0 = i * Q_BLOCK
        qb = lax.dynamic_slice_in_dim(q, q0, Q_BLOCK, axis=1)
        gb = lax.dynamic_slice_in_dim(gates, q0, Q_BLOCK, axis=1)
        wb = lax.dynamic_slice_in_dim(kw_pad, q0, WINDOW + Q_BLOCK, axis=1)
        q_pos = q0 + jnp.arange(Q_BLOCK, dtype=jnp.int32)
        w_pos = q0 - WINDOW + jnp.arange(WINDOW + Q_BLOCK, dtype=jnp.int32)
        return nsa_attend(qb, q_pos, gb, kc, vc, ks_blk, vs_blk, wb[:, :, 0], wb[:, :, 1], w_pos, rel_table)

    out = lax.map(block, jnp.arange(S // Q_BLOCK, dtype=jnp.int32))
    return out.transpose(1, 0, 2, 3).reshape(B, S, D_B)


def merge_out(x, a, z_a, o_b, z_b, w_out):
    B, S = x.shape[:2]
    mix = jnp.concatenate([a.reshape(B, S, D_A) * jax.nn.silu(z_a.astype(jnp.float32)),
                           o_b * jax.nn.silu(z_b.astype(jnp.float32))], axis=-1)
    y = x.astype(jnp.float32) + jnp.einsum('bse,ed->bsd', mix, w_out.astype(jnp.float32))
    return y.astype(x.dtype)


def last_rows(x, n):
    S = x.shape[1]
    if S >= n:
        return x[:, S - n:]
    return jnp.pad(x, ((0, 0), (n - S, 0)) + ((0, 0),) * (x.ndim - 2))


def setup_inputs(seed: int = 0) -> dict:
    key = jax.random.key(seed)
    ks = jax.random.split(key, 20)
    f32 = jnp.float32
    nrm = jax.random.normal
    n_pages = PAST_LEN // PAGE_SIZE
    n_used = DEC_BATCH * n_pages
    n_phys = n_used + n_used // 4
    win_buf = min(WINDOW, PAST_LEN)
    page_table = jax.random.permutation(ks[5], n_phys)[:n_used].reshape(DEC_BATCH, n_pages).astype(jnp.int32)
    return {
        'x_prompt': nrm(ks[0], (BATCH, SEQ, D_MODEL), f32),
        'x_sample': nrm(ks[1], (DEC_BATCH, DEC_SEQ, D_MODEL), f32),
        'cache_cmp_kv': nrm(ks[2], (DEPTH, n_phys, PAGE_SIZE, 2, N_KV, HEAD_DIM), f32),
        'cache_sel_kv': nrm(ks[3], (DEPTH, n_phys, PAGE_SIZE, 2, N_KV, HEAD_DIM), f32),
        'state_win_kv': nrm(ks[4], (DEPTH, DEC_BATCH, win_buf, 2, N_KV, HEAD_DIM), f32),
        'page_table': page_table,
        'norm_g': 1.0 + 0.02 * nrm(ks[6], (DEPTH, D_MODEL), f32),
        'w_in': nrm(ks[7], (DEPTH, D_MODEL, D_IN), f32) * D_MODEL ** -0.5,
        'ln_v_g': 1.0 + 0.02 * nrm(ks[8], (DEPTH, D_A), f32),
        'spatial_w': nrm(ks[9], (DEPTH, A_GROUPS, CHUNK, CHUNK), f32) * CHUNK ** -0.5,
        'spatial_b': 1.0 + 0.02 * nrm(ks[10], (DEPTH, A_GROUPS, CHUNK), f32),
        'cmp_pe': 0.1 * nrm(ks[11], (DEPTH, 2, CMP_BLOCK, HEAD_DIM), f32),
        'cmp_w1': nrm(ks[12], (DEPTH, 2, CMP_R, CMP_STRIDE, HEAD_DIM, CMP_HIDDEN), f32) * (CMP_BLOCK * HEAD_DIM) ** -0.5,
        'cmp_b1': 0.01 * nrm(ks[13], (DEPTH, 2, CMP_HIDDEN), f32),
        'cmp_w2': nrm(ks[14], (DEPTH, 2, CMP_HIDDEN, HEAD_DIM), f32) * CMP_HIDDEN ** -0.5,
        'cmp_b2': 0.01 * nrm(ks[15], (DEPTH, 2, HEAD_DIM), f32),
        'rel_table': 0.5 * nrm(ks[16], (N_BUCKETS, N_HEADS), f32),
        'w_out': nrm(ks[17], (DEPTH, D_MIX, D_MODEL), f32) * D_MIX ** -0.5,
        'final_g': 1.0 + 0.02 * nrm(ks[18], (D_MODEL,), f32),
    }


def reference(x_prompt, x_sample, cache_cmp_kv, cache_sel_kv, state_win_kv, page_table,
              norm_g, w_in, ln_v_g, spatial_w, spatial_b, cmp_pe, cmp_w1, cmp_b1,
              cmp_w2, cmp_b2, rel_table, w_out, final_g):
    n_pages = PAST_LEN // PAGE_SIZE
    win_buf = min(WINDOW, PAST_LEN)
    B, S = x_prompt.shape[:2]
    DB, DS = x_sample.shape[:2]
    xp, xs = x_prompt, x_sample
    cmp_p, sel_p, win_p = [], [], []
    cmp_s, sel_s, win_s, chv_s = [], [], [], []
    for l in range(DEPTH):
        u, v, za, q, kvc, kvs, kvw, gates, zb = split_proj(xp, norm_g[l], w_in[l])
        ua, va = chunk_mlp_prep(u, v, ln_v_g[l])
        a = spatial_gate(ua.reshape(B, S // CHUNK, CHUNK, A_GROUPS, HEAD_DIM),
                         va.reshape(B, S // CHUNK, CHUNK, A_GROUPS, HEAD_DIM),
                         spatial_w[l], spatial_b[l])
        kc, vc = compress_kv(kvc, cmp_pe[l], cmp_w1[l], cmp_b1[l], cmp_w2[l], cmp_b2[l])
        ks_blk, vs_blk = sel_blocks(kvs)
        o = nsa_prompt(q, gates, kc, vc, ks_blk, vs_blk, kvw, rel_table)
        xp = merge_out(xp, a, za, o, zb, w_out[l])
        cmp_p.append(kvc)
        sel_p.append(kvs)
        win_p.append(last_rows(kvw, win_buf))
        u, v, za, q, kvc, kvs, kvw, gates, zb = split_proj(xs, norm_g[l], w_in[l])
        ua, va = chunk_mlp_prep(u, v, ln_v_g[l])
        a = spatial_gate(ua[:, None], va[:, None], spatial_w[l], spatial_b[l])[:, 0]
        past_c = cache_cmp_kv[l][page_table].reshape(DB, n_pages * PAGE_SIZE, 2, N_KV, HEAD_DIM)
        past_s = cache_sel_kv[l][page_table].reshape(DB, n_pages * PAGE_SIZE, 2, N_KV, HEAD_DIM)
        full_c = jnp.concatenate([past_c, kvc.astype(past_c.dtype)], axis=1)
        full_s = jnp.concatenate([past_s, kvs.astype(past_s.dtype)], axis=1)
        kc, vc = compress_kv(full_c, cmp_pe[l], cmp_w1[l], cmp_b1[l], cmp_w2[l], cmp_b2[l])
        ks_blk, vs_blk = sel_blocks(full_s)
        win = jnp.concatenate([state_win_kv[l], kvw.astype(state_win_kv.dtype)], axis=1)
        w_pos = PAST_LEN - win_buf + jnp.arange(win_buf + DS, dtype=jnp.int32)
        q_pos = PAST_LEN + jnp.arange(DS, dtype=jnp.int32)
        winf = win.astype(jnp.float32)
        o = nsa_attend(q, q_pos, gates, kc, vc, ks_blk, vs_blk, winf[:, :, 0], winf[:, :, 1], w_pos, rel_table)
        xs = merge_out(xs, a, za, o, zb, w_out[l])
        cmp_s.append(kvc)
        sel_s.append(kvs)
        win_s.append(win[:, DS:])
        chv_s.append(va.reshape(DB, DS, D_A).astype(x_sample.dtype))
    y_prompt = rmsnorm(xp, final_g)
    y_sample = rmsnorm(xs, final_g)
    new_cmp_kv_prompt = jnp.stack(cmp_p)
    new_sel_kv_prompt = jnp.stack(sel_p)
    new_win_kv_prompt = jnp.stack(win_p)
    new_cmp_kv_sample = jnp.stack(cmp_s)
    new_sel_kv_sample = jnp.stack(sel_s)
    new_win_kv_sample = jnp.stack(win_s)
    new_chunk_v_sample = jnp.stack(chv_s)
    return (y_prompt, y_sample, new_cmp_kv_prompt, new_sel_kv_prompt, new_win_kv_prompt,
            new_cmp_kv_sample, new_sel_kv_sample, new_win_kv_sample, new_chunk_v_sample)
```

```cpp
#include <hip/hip_runtime.h>
#include <cstdio>
#include <cstdint>

#ifndef CHECK_SUBSET
#define CHECK_SUBSET 0
#endif
#ifndef CHECK_TOL
#define CHECK_TOL 0.03f
#endif
#ifndef REP_PHASE
#define REP_PHASE -1
#endif
#ifndef PROBE_VAR
#define PROBE_VAR 0
#define REP_COUNT 4
#endif
#ifndef MK_N_LAUNCHES
#define MK_N_LAUNCHES 1
#endif

#define LAS __attribute__((address_space(3)))
#define GAS __attribute__((address_space(1)))
typedef unsigned short bf16_t;
typedef short bf16x8 __attribute__((ext_vector_type(8)));
typedef short s16x4 __attribute__((ext_vector_type(4)));
typedef float f32x4 __attribute__((ext_vector_type(4)));
typedef float f32x2 __attribute__((ext_vector_type(2)));
typedef unsigned u32x4 __attribute__((ext_vector_type(4)));
typedef unsigned u32x2 __attribute__((ext_vector_type(2)));
typedef __bf16 bf16x2_t __attribute__((ext_vector_type(2)));
typedef GAS unsigned gu32;

constexpr int DM = 1024, NB = 4, SEQ = 8192, MP = NB * SEQ;
constexpr int DB = 32, DS = 8, MS = DB * DS, MT = MP + MS;
constexpr int PAST = 16384, PAGE = 128, NPAGES = 128;
constexpr int D_IN = 3352, NPAD = 3584;
constexpr int NCS = 1024;
constexpr float LOG2E = 1.4426950408889634f;
constexpr size_t O_YP = 0, O_YS = 33554432, O_CP = 33816576, O_SP = 42205184, O_WP = 50593792, O_CS = 51118080, O_SS = 51183616, O_WS = 51249152, O_CV = 55443456;

constexpr size_t MiB = 1u << 20;
constexpr size_t WS_CTL = 0, CTL_ZERO_BYTES = 64 * 1024;
constexpr size_t WS_WIN = 2 * MiB;
constexpr size_t WS_WOUT = 10 * MiB;
constexpr size_t WS_W1T = 12 * MiB;
constexpr size_t WS_W2T = 14 * MiB;
constexpr size_t WS_SW = 15 * MiB;
constexpr size_t WS_HB = 15 * MiB + 512 * 1024;
constexpr size_t WS_GATES = 16 * MiB;
constexpr size_t WS_H = 20 * MiB;
constexpr size_t WS_UA = 86 * MiB;
constexpr size_t WS_VG = 120 * MiB;
constexpr size_t WS_Q = 154 * MiB;
constexpr size_t WS_MIX = 188 * MiB;
constexpr size_t WS_KVS = 254 * MiB;
constexpr size_t WS_KVW = 272 * MiB;
constexpr size_t WS_AC = 290 * MiB;
constexpr size_t WS_HC = 308 * MiB;
constexpr size_t WS_KC = 313 * MiB;
constexpr size_t WS_KCS = 315 * MiB;
constexpr size_t WS_HCS = 332 * MiB;
constexpr size_t WS_ACS = 400 * MiB;
constexpr size_t WS_MIXO = 660 * MiB;
constexpr size_t WS_DBG = 726 * MiB;
constexpr size_t WS_END = 792 * MiB;

constexpr int CW_TMO = 0;
constexpr int CW_BAR = 4096;
constexpr int CW_NFAIL = 64, CW_NFAILC = 128, CW_NITEM = 192, CW_SOUT = 320;
constexpr int CW_PANEL = 9216;
constexpr size_t WS_XS = 1 * MiB;

constexpr int RING_BYTES = 131072;
constexpr int LDS_MISC = 150528;
constexpr int LDS_BYTES = 151552;
constexpr int AW_V = 0, AW_VP = 160, AW_IMP = 10240, AW_IMPN = 272, AW_MSK = 10240 + 4 * 272 * 4, AW_BYTES = 14848;
constexpr int LDS_TB = 8 * AW_BYTES;
constexpr int SP_PITCH = 136, SP_BYTES = 128 * SP_PITCH;

#define RLX_AGENT __ATOMIC_RELAXED, __HIP_MEMORY_SCOPE_AGENT
#define LDS_WAIT() asm volatile("s_waitcnt lgkmcnt(0)" ::: "memory")
#define VM_WAIT() asm volatile("s_waitcnt vmcnt(0)" ::: "memory")
#define LDS_BARRIER() asm volatile("s_waitcnt lgkmcnt(0)\n\ts_barrier" ::: "memory")

__device__ __forceinline__ unsigned f2bf(float f) { unsigned u = __builtin_bit_cast(unsigned, f); return (u + 0x7fffu + ((u >> 16) & 1u)) >> 16; }
__device__ __forceinline__ unsigned pk2(float lo, float hi) { f32x2 v = {lo, hi}; bf16x2_t b = __builtin_convertvector(v, bf16x2_t); return __builtin_bit_cast(unsigned, b); }
__device__ __forceinline__ float bf2f(unsigned short b) { return __builtin_bit_cast(float, (unsigned)b << 16); }
__device__ __forceinline__ float bflo(unsigned w) { return __builtin_bit_cast(float, w << 16); }
__device__ __forceinline__ float bfhi(unsigned w) { return __builtin_bit_cast(float, w & 0xffff0000u); }
__device__ __forceinline__ float fast_sigmoid(float x) { return __builtin_amdgcn_rcpf(1.f + __builtin_amdgcn_exp2f(-x * LOG2E)); }
__device__ __forceinline__ float silu_f(float x) { return x * fast_sigmoid(x); }
__device__ __forceinline__ float gelu_f(float x) { const float u2 = x * (1.5957691216057308f + 0.07135481627466319f * x * x); return x * fast_sigmoid(u2); }
__device__ __forceinline__ float wave_sum(float v) {
    v += __builtin_bit_cast(float, __builtin_amdgcn_update_dpp(0, __builtin_bit_cast(int, v), 0xB1, 0xF, 0xF, true));
    v += __builtin_bit_cast(float, __builtin_amdgcn_update_dpp(0, __builtin_bit_cast(int, v), 0x4E, 0xF, 0xF, true));
    v += __builtin_bit_cast(float, __builtin_amdgcn_update_dpp(0, __builtin_bit_cast(int, v), 0x124, 0xF, 0xF, true));
    v += __builtin_bit_cast(float, __builtin_amdgcn_update_dpp(0, __builtin_bit_cast(int, v), 0x128, 0xF, 0xF, true));
    { auto a = __builtin_amdgcn_permlane16_swap(__float_as_uint(v), __float_as_uint(v), false, false); v = __uint_as_float(a[0]) + __uint_as_float(a[1]); }
    { auto c = __builtin_amdgcn_permlane32_swap(__float_as_uint(v), __float_as_uint(v), false, false); v = __uint_as_float(c[0]) + __uint_as_float(c[1]); }
    return v;
}

namespace pg8 {
constexpr int BM = 256, BK = 64, HALF = 128, HTB = HALF * BK * 2, NXCD = 8, WGM = 8;
__host__ __device__ __forceinline__ int lds_byte(int r, int c) { const int st = (r >> 4) * 2 + (c >> 5), rr = r & 15, cc = c & 31, ob = rr * 64 + cc * 2; return st * 1024 + (ob ^ (((ob >> 9) & 1) << 5)); }
__host__ __device__ __forceinline__ void stage_rc(int b, int& R, int& C) { const int st = b / 1024, sb = b % 1024, swz = sb ^ (((sb >> 9) & 1) << 5); R = (st >> 1) * 16 + swz / 64; C = (st & 1) * 32 + (swz % 64) / 2; }
__host__ __device__ __forceinline__ int perm32(int rho) { const int n = rho >> 4, i = rho & 15; return 8 * (i >> 2) + 4 * n + (i & 3); }

struct Unit { int pm, pn; };
struct Gemm { const bf16_t* A; const bf16_t* Bt; int lda, K; };

struct StaticOrder {
    int nM, nN, nwg, G, c;
    __device__ void init(int M, int N, int G_, int c_) { nM = M / BM; nN = N / BM; nwg = nM * nN; G = G_; c = c_; }
    __device__ bool next(int i, Unit& u) const {
        const long L = (long)i * G + c; if (L >= nwg) return false;
        int wgid = (int)L; { const int q = nwg / NXCD, r = nwg % NXCD, xcd = wgid % NXCD, off = wgid / NXCD; wgid = (xcd < r ? xcd * (q + 1) : r * (q + 1) + (xcd - r) * q) + off; }
        const int nig = WGM * nN, gid = wgid / nig, fm = gid * WGM, gsz = (nM - fm) < WGM ? (nM - fm) : WGM;
        u.pm = fm + ((wgid % nig) % gsz); u.pn = (wgid % nig) / gsz; return true;
    }
};
struct KvOrder {
    int nunits, mt_per_kv, G, c;
    __device__ void init(int mt_per_kv_, int G_, int c_) { mt_per_kv = mt_per_kv_; nunits = 2 * mt_per_kv_; G = G_; c = c_; }
    __device__ bool next(int i, Unit& u) const { const int L = i * G + c; if (L >= nunits) return false; u.pm = L; u.pn = L / mt_per_kv; return true; }
};

template <class S_> struct SubOrder { S_ S; int i0, n; __device__ bool next(int i, Unit& u) const { return i < n && S.next(i0 + i, u); } };
struct OneUnit { int pm, pn; bool on; __device__ bool next(int i, Unit& u) const { if (i != 0 || !on) return false; u.pm = pm; u.pn = pn; return true; } };

template <class Epi, class Sched>
__device__ __forceinline__ void gemm_phase(LAS unsigned char* lds, const Gemm g, const Sched& S, const Epi& E) {
    const int tid = threadIdx.x, wid = __builtin_amdgcn_readfirstlane(tid >> 6), lane = tid & 63, wr = wid >> 2, wc = wid & 3, fr = lane & 15, fq = lane >> 4;
    const int K = g.K, nt = K / BK, lda = g.lda;
    unsigned voffA[2], voffB[2];
#pragma unroll
    for (int i = 0; i < 2; ++i) { int R, C; stage_rc(tid * 16 + i * 8192, R, C); const int Rb = Epi::PERM ? ((R & ~31) + perm32(R & 31)) : R;
        voffA[i] = (unsigned)(R * lda + C) * 2u; voffB[i] = (unsigned)(Rb * K + C) * 2u; }
    const size_t kstep = (size_t)(BK * 2);
    const size_t hstepA = (size_t)HALF * lda * 2, hstepB = (size_t)HALF * K * 2;
    const size_t tstepA = 2 * hstepA, tstepB = 2 * hstepB;
    const unsigned ldsw = (unsigned)wid * 1024u;
    const int aoff = lds_byte(wr * 64 + fr, fq * 8), boff = lds_byte(wc * 32 + fr, fq * 8);
#define PG8_SA(b, h) (((b) * 2 + (h)) * HTB)
#define PG8_SB(b, h) ((4 + (b) * 2 + (h)) * HTB)
#define PG8_STAGE(bufoff, gbase, voff) do { _Pragma("unroll") for (int _i = 0; _i < 2; ++_i) \
        __builtin_amdgcn_global_load_lds((const unsigned*)((const char*)(gbase) + (voff)[_i]), (LAS unsigned*)(lds + (bufoff) + ldsw + _i * 8192), 16, 0, 0); } while (0)
#define PG8_LDA(dst, b, h) do { _Pragma("unroll") for (int m = 0; m < 4; ++m) _Pragma("unroll") for (int k = 0; k < 2; ++k) dst[m][k] = *(const LAS bf16x8*)(lds + PG8_SA(b, h) + aoff + m * 2048 + k * 1024); } while (0)
#define PG8_LDB(dst, b, h) do { _Pragma("unroll") for (int n = 0; n < 2; ++n) _Pragma("unroll") for (int k = 0; k < 2; ++k) dst[n][k] = *(const LAS bf16x8*)(lds + PG8_SB(b, h) + boff + n * 2048 + k * 1024); } while (0)
#define PG8_MMA(ai, bj, At, Bt) do { __builtin_amdgcn_s_setprio(1); _Pragma("unroll") for (int m = 0; m < 4; ++m) _Pragma("unroll") for (int n = 0; n < 2; ++n) _Pragma("unroll") for (int k = 0; k < 2; ++k) \
        acc[ai][bj][m][n] = __builtin_amdgcn_mfma_f32_16x16x32_bf16(Bt[n][k], At[m][k], acc[ai][bj][m][n], 0, 0, 0); __builtin_amdgcn_s_setprio(0); } while (0)
#define PG8_WAIT_V(n) asm volatile("s_waitcnt vmcnt(" #n ")" ::: "memory")
#define PG8_WAIT_L(n) asm volatile("s_waitcnt lgkmcnt(" #n ")" ::: "memory")
#define PG8_BAR __builtin_amdgcn_s_barrier()
#define PG8_SCHED __builtin_amdgcn_sched_barrier(0)
    Unit cur, nxt; int ui = 0;
    if (!S.next(0, cur)) return;
    f32x4 acc[2][2][4][2];
#pragma unroll
    for (int a = 0; a < 2; ++a)
#pragma unroll
        for (int b = 0; b < 2; ++b)
#pragma unroll
            for (int m = 0; m < 4; ++m)
#pragma unroll
                for (int n = 0; n < 2; ++n) acc[a][b][m][n] = (f32x4){0.f, 0.f, 0.f, 0.f};
    bf16x8 At[4][2], B0[2][2], B1[2][2];
    const char* cA = (const char*)g.A + (size_t)cur.pm * tstepA; const char* cB = (const char*)g.Bt + (size_t)cur.pn * tstepB;
    PG8_STAGE(PG8_SB(0, 0), cB, voffB); PG8_STAGE(PG8_SB(0, 1), cB + hstepB, voffB); PG8_STAGE(PG8_SA(0, 0), cA, voffA); PG8_STAGE(PG8_SA(0, 1), cA + hstepA, voffA);
    if (wr == 1) PG8_BAR;
    PG8_WAIT_V(2); PG8_BAR;
    PG8_STAGE(PG8_SB(1, 0), cB + kstep, voffB); PG8_STAGE(PG8_SA(1, 0), cA + kstep, voffA); PG8_STAGE(PG8_SB(1, 1), cB + hstepB + kstep, voffB);
    PG8_WAIT_V(6); PG8_BAR;
    for (;;) {
        const bool has_next = S.next(ui + 1, nxt);
        const char* nA = has_next ? (const char*)g.A + (size_t)nxt.pm * tstepA : cA; const char* nB = has_next ? (const char*)g.Bt + (size_t)nxt.pn * tstepB : cB;
        for (int t = 0; t < nt; t += 2) {
            const bool last = (t == nt - 2);
            const char* a1 = cA + (size_t)(t + 1) * kstep;
            const char* a2 = last ? nA : cA + (size_t)(t + 2) * kstep; const char* b2 = last ? nB : cB + (size_t)(t + 2) * kstep;
            const char* a3 = a2 + kstep; const char* b3 = b2 + kstep;
            PG8_LDB(B0, 0, 0); PG8_LDB(B1, 0, 1); PG8_SCHED; PG8_LDA(At, 0, 0); PG8_STAGE(PG8_SA(1, 1), a1 + hstepA, voffA);
            PG8_WAIT_V(8); PG8_WAIT_L(0); PG8_BAR; PG8_MMA(0, 0, At, B0); PG8_MMA(0, 1, At, B1); PG8_BAR; PG8_SCHED;
            PG8_LDA(At, 0, 1); PG8_STAGE(PG8_SB(0, 0), b2, voffB); PG8_STAGE(PG8_SB(0, 1), b2 + hstepB, voffB); PG8_STAGE(PG8_SA(0, 0), a2, voffA);
            PG8_WAIT_V(8); PG8_WAIT_L(0); PG8_BAR; PG8_MMA(1, 0, At, B0); PG8_MMA(1, 1, At, B1); PG8_BAR; PG8_SCHED;
            PG8_LDB(B0, 1, 0); PG8_LDB(B1, 1, 1); PG8_SCHED; PG8_LDA(At, 1, 0); PG8_STAGE(PG8_SA(0, 1), a2 + hstepA, voffA);
            PG8_WAIT_V(8); PG8_WAIT_L(0); PG8_BAR; PG8_MMA(0, 0, At, B0); PG8_MMA(0, 1, At, B1); PG8_BAR; PG8_SCHED;
            PG8_LDA(At, 1, 1); PG8_STAGE(PG8_SB(1, 0), b3, voffB); PG8_STAGE(PG8_SB(1, 1), b3 + hstepB, voffB); PG8_STAGE(PG8_SA(1, 0), a3, voffA);
            PG8_WAIT_V(8); PG8_WAIT_L(0); PG8_BAR; PG8_MMA(1, 0, At, B0); PG8_MMA(1, 1, At, B1); PG8_BAR; PG8_SCHED;
        }
        if (wr == 0) PG8_BAR;
        E(acc, cur, wr, wc, fr, fq);
        if (!has_next) break;
#pragma unroll
        for (int a = 0; a < 2; ++a)
#pragma unroll
            for (int b = 0; b < 2; ++b)
#pragma unroll
                for (int m = 0; m < 4; ++m)
#pragma unroll
                    for (int n = 0; n < 2; ++n) acc[a][b][m][n] = (f32x4){0.f, 0.f, 0.f, 0.f};
        cur = nxt; cA = nA; cB = nB; ++ui;
        if (wr == 1) PG8_BAR;
    }
    PG8_WAIT_V(0);
    PG8_BAR;
#undef PG8_SA
#undef PG8_SB
#undef PG8_STAGE
#undef PG8_LDA
#undef PG8_LDB
#undef PG8_MMA
#undef PG8_WAIT_V
#undef PG8_WAIT_L
#undef PG8_BAR
#undef PG8_SCHED
}
}

__device__ __forceinline__ void st_bf16x8(bf16_t* p, const f32x4& v0, const f32x4& v1) {
    u32x4 w; w.x = pk2(v0[0], v0[1]); w.y = pk2(v0[2], v0[3]); w.z = pk2(v1[0], v1[1]); w.w = pk2(v1[2], v1[3]); *(u32x4*)p = w;
}
template <int ACT>
__device__ __forceinline__ void epi_store_act(const f32x4 (&acc)[2][2][4][2], bf16_t* dst0, int ld, int rowbase, int colbase) {
#pragma unroll
    for (int ai = 0; ai < 2; ++ai)
#pragma unroll
        for (int m = 0; m < 4; ++m) {
            bf16_t* rp = dst0 + (size_t)(rowbase + ai * 128 + m * 16) * ld + colbase;
#pragma unroll
            for (int bj = 0; bj < 2; ++bj) {
                f32x4 v0 = acc[ai][bj][m][0], v1 = acc[ai][bj][m][1];
                if (ACT == 0) {
#pragma unroll
                    for (int e = 0; e < 4; ++e) { v0[e] = gelu_f(v0[e]); v1[e] = gelu_f(v1[e]); }
                } else if (ACT == 1) {
#pragma unroll
                    for (int e = 0; e < 4; ++e) { v0[e] = silu_f(v0[e]); v1[e] = silu_f(v1[e]); }
                } else { v0 = v0 * (0.125f * LOG2E); v1 = v1 * (0.125f * LOG2E); }
                st_bf16x8(rp + bj * 128, v0, v1);
            }
            asm volatile("" ::: "memory");
        }
}
struct EpiInProj {
    static constexpr bool PERM = true;
    unsigned char* ws; float* out;
    __device__ __forceinline__ void operator()(const f32x4 (&acc)[2][2][4][2], const pg8::Unit& u, int wr, int wc, int fr, int fq) const {
        const int pn = u.pn;
        const bool sample = (u.pm == MP / 256);
        const int rowbase = u.pm * 256 + wr * 64 + fr, cb = wc * 32 + 8 * fq;
        if (pn < 2) epi_store_act<0>(acc, (bf16_t*)(ws + WS_UA), 512, rowbase, pn * 256 + cb);
        else if (pn < 4) epi_store_act<0>(acc, (bf16_t*)(ws + WS_VG), 512, rowbase, (pn - 2) * 256 + cb);
        else if (pn < 6) epi_store_act<1>(acc, (bf16_t*)(ws + WS_MIX), 1024, rowbase, (pn - 4) * 256 + cb);
        else if (pn < 8) epi_store_act<2>(acc, (bf16_t*)(ws + WS_Q), 512, rowbase, (pn - 6) * 256 + cb);
        else if (pn == 11 || pn == 12) epi_store_act<1>(acc, (bf16_t*)(ws + WS_MIX), 1024, rowbase, 512 + (pn - 11) * 256 + cb);
        else if (pn == 13) {
            if (cb < 24) {
                float* gbase = (float*)(ws + WS_GATES);
#pragma unroll
                for (int ai = 0; ai < 2; ++ai)
#pragma unroll
                    for (int m = 0; m < 4; ++m) {
                        f32x4 v0 = acc[ai][0][m][0], v1 = acc[ai][0][m][1];
#pragma unroll
                        for (int e = 0; e < 4; ++e) { v0[e] = fast_sigmoid(v0[e]); v1[e] = fast_sigmoid(v1[e]); }
                        float* gp = gbase + (size_t)(rowbase + ai * 128 + m * 16) * 24 + cb; *(f32x4*)gp = v0; *(f32x4*)(gp + 4) = v1;
                    }
            }
        } else {
            const size_t fbase = sample ? (pn == 8 ? O_CS : O_SS) : (pn == 8 ? O_CP : O_SP);
            bf16_t* bb = (bf16_t*)(ws + (pn == 9 ? WS_KVS : WS_KVW));
#pragma unroll
            for (int ai = 0; ai < 2; ++ai)
#pragma unroll
                for (int m = 0; m < 4; ++m) {
                    const int row = rowbase + ai * 128 + m * 16;
#pragma unroll
                    for (int bj = 0; bj < 2; ++bj) {
                        const int c = bj * 128 + cb;
                        const f32x4 v0 = acc[ai][bj][m][0], v1 = acc[ai][bj][m][1];
                        float* fo = nullptr;
                        if (pn != 10) fo = out + fbase + (size_t)(sample ? row - MP : row) * 256 + c;
                        else if (sample) { const int rs = row - MP; fo = out + O_WS + ((size_t)(rs >> 3) * 512 + 504 + (rs & 7)) * 256 + c; }
                        else { const int t = row & (SEQ - 1); if (t >= SEQ - 512) fo = out + O_WP + ((size_t)(row >> 13) * 512 + (t - (SEQ - 512))) * 256 + c; }
                        if (fo) { *(f32x4*)fo = v0; *(f32x4*)(fo + 4) = v1; }
                        if (!sample) {
                            if (pn == 8) { const int kv = c >> 7, g = (c >> 6) & 1, d = c & 63, b = row >> 13, t = row & (SEQ - 1);
                                st_bf16x8((bf16_t*)(ws + WS_AC) + ((size_t)(((kv * NB + b) * 2 + g) * 512 + (t >> 4))) * 1024 + (t & 15) * 64 + d, v0, v1); }
                            else st_bf16x8(bb + (size_t)row * 256 + c, v0, v1);
                        }
                    }
                    asm volatile("" ::: "memory");
                }
        }
    }
};
struct EpiOut {
    static constexpr bool PERM = true;
    const float* xp; const float* xs; float* out;
    __device__ __forceinline__ void operator()(const f32x4 (&acc)[2][2][4][2], const pg8::Unit& u, int wr, int wc, int fr, int fq) const {
        const int row0 = u.pm * 256 + wr * 64 + fr, c0 = u.pn * 256 + wc * 32 + 8 * fq;
        const float* xb = (row0 < MP) ? xp + (size_t)row0 * DM + c0 : xs + (size_t)(row0 - MP) * DM + c0;
        float* ob = out + (size_t)row0 * DM + c0;
#pragma unroll
        for (int ai = 0; ai < 2; ++ai) {
            f32x4 x[4][2][2];
#pragma unroll
            for (int m = 0; m < 4; ++m)
#pragma unroll
                for (int bj = 0; bj < 2; ++bj) { const float* p = xb + (size_t)(ai * 128 + m * 16) * DM + bj * 128; x[m][bj][0] = *(const f32x4*)p; x[m][bj][1] = *(const f32x4*)(p + 4); }
#pragma unroll
            for (int m = 0; m < 4; ++m)
#pragma unroll
                for (int bj = 0; bj < 2; ++bj) { float* o = ob + (size_t)(ai * 128 + m * 16) * DM + bj * 128;
                    *(f32x4*)o = acc[ai][bj][m][0] + x[m][bj][0]; *(f32x4*)(o + 4) = acc[ai][bj][m][1] + x[m][bj][1]; }
            asm volatile("" ::: "memory");
        }
    }
};
__device__ __forceinline__ float xrow_sum(float m);
struct EpiOutNorm {
    static constexpr bool PERM = true;
    const float* xp; const float* gw; float* out; unsigned* xbuf; unsigned* cnt; unsigned* tmo; LAS unsigned char* tb;
    __device__ __forceinline__ void operator()(f32x4 (&acc)[2][2][4][2], const pg8::Unit& u, int wr, int wc, int fr, int fq) const {
        const int wid = wr * 4 + wc, lane = fq * 16 + fr;
        const int row0 = u.pm * 256 + wr * 64 + fr, c0 = u.pn * 256 + wc * 32 + 8 * fq;
        const float* xb = xp + (size_t)row0 * DM + c0;
        LAS float* P = (LAS float*)tb; LAS float* S = P + 1024; LAS unsigned* flag = (LAS unsigned*)(S + 256);
#pragma unroll
        for (int ai = 0; ai < 2; ++ai) {
            f32x4 x[4][2][2];
#pragma unroll
            for (int m = 0; m < 4; ++m)
#pragma unroll
                for (int bj = 0; bj < 2; ++bj) { const float* p = xb + (size_t)(ai * 128 + m * 16) * DM + bj * 128; x[m][bj][0] = *(const f32x4*)p; x[m][bj][1] = *(const f32x4*)(p + 4); }
#pragma unroll
            for (int m = 0; m < 4; ++m) { float s = 0.f;
#pragma unroll
                for (int bj = 0; bj < 2; ++bj)
#pragma unroll
                    for (int n = 0; n < 2; ++n) { const f32x4 v = acc[ai][bj][m][n] + x[m][bj][n]; acc[ai][bj][m][n] = v; s += (v[0] * v[0] + v[1] * v[1]) + (v[2] * v[2] + v[3] * v[3]); }
                s = xrow_sum(s);
                if (fq == 0) P[(ai * 128 + wr * 64 + m * 16 + fr) * 4 + wc] = s; }
            asm volatile("" ::: "memory");
        }
        LDS_BARRIER();
        const int row = wid * 32 + (lane & 31);
        if (lane < 32) { const f32x4 p = *(const LAS f32x4*)(P + row * 4);
            __hip_atomic_store(xbuf + ((size_t)(u.pm * 256 + row) * 4 + u.pn), __float_as_uint((p[0] + p[1]) + (p[2] + p[3])), RLX_AGENT); }
        VM_WAIT();
        if (lane == 0) __hip_atomic_fetch_add(cnt + 32 * u.pm, 1u, RLX_AGENT);
        if (wid == 0) {
            bool dead = false; unsigned sp = 0;
            while ((unsigned)__builtin_amdgcn_readfirstlane(__hip_atomic_load(cnt + 32 * u.pm, RLX_AGENT)) < 32u) {
                __builtin_amdgcn_s_sleep(2);
                if (++sp > (1u << 22)) { dead = true; break; } }
            if (dead && lane == 0) __hip_atomic_store(tmo, 1u, RLX_AGENT);
            __builtin_amdgcn_fence(__ATOMIC_ACQUIRE, "agent");
            if (lane == 0) flag[0] = dead ? 1u : 0u;
        }
        asm volatile("s_waitcnt vmcnt(0) lgkmcnt(0)\n\ts_barrier" ::: "memory");
        const bool bad = flag[0] != 0u;
        if (lane < 32) { const unsigned* sl = xbuf + (size_t)(u.pm * 256 + row) * 4;
            const float t0 = __uint_as_float(__hip_atomic_load(sl + 0, RLX_AGENT)), t1 = __uint_as_float(__hip_atomic_load(sl + 1, RLX_AGENT));
            const float t2 = __uint_as_float(__hip_atomic_load(sl + 2, RLX_AGENT)), t3 = __uint_as_float(__hip_atomic_load(sl + 3, RLX_AGENT));
            float rs = 1.f / sqrtf(((t0 + t1) + (t2 + t3)) * (1.f / DM) + 1e-6f);
            if (bad) rs = __builtin_nanf("");
            S[row] = rs; }
        LDS_BARRIER();
        f32x4 g[2][2];
#pragma unroll
        for (int bj = 0; bj < 2; ++bj) { g[bj][0] = *(const f32x4*)(gw + c0 + bj * 128); g[bj][1] = *(const f32x4*)(gw + c0 + bj * 128 + 4); }
        float* ob = out + (size_t)row0 * DM + c0;
#pragma unroll
        for (int ai = 0; ai < 2; ++ai) {
#pragma unroll
            for (int m = 0; m < 4; ++m) { const float rs = S[ai * 128 + wr * 64 + m * 16 + fr];
#pragma unroll
                for (int bj = 0; bj < 2; ++bj) { float* o = ob + (size_t)(ai * 128 + m * 16) * DM + bj * 128;
                    *(f32x4*)o = acc[ai][bj][m][0] * rs * g[bj][0]; *(f32x4*)(o + 4) = acc[ai][bj][m][1] * rs * g[bj][1]; } }
            asm volatile("" ::: "memory");
        }
    }
};
template <int ACT> struct EpiCmp {
    static constexpr bool PERM = true;
    bf16_t* O; int ldc; const float* bias; int bstride; int ncols;
    __device__ __forceinline__ void operator()(const f32x4 (&acc)[2][2][4][2], const pg8::Unit& u, int wr, int wc, int fr, int fq) const {
#pragma unroll
        for (int bj = 0; bj < 2; ++bj) {
            const int c = bj * 128 + wc * 32 + 8 * fq;
            if (c < ncols) {
                const f32x4 b0 = *(const f32x4*)(bias + u.pn * bstride + c), b1 = *(const f32x4*)(bias + u.pn * bstride + c + 4);
#pragma unroll
                for (int ai = 0; ai < 2; ++ai)
#pragma unroll
                    for (int m = 0; m < 4; ++m) {
                        const size_t row = (size_t)u.pm * 256 + ai * 128 + wr * 64 + m * 16 + fr;
                        f32x4 v0 = acc[ai][bj][m][0] + b0, v1 = acc[ai][bj][m][1] + b1;
                        if (ACT == 1) {
#pragma unroll
                            for (int e = 0; e < 4; ++e) { v0[e] = gelu_f(v0[e]); v1[e] = gelu_f(v1[e]); }
                        }
                        st_bf16x8(O + row * ldc + c, v0, v1);
                    }
            }
        }
    }
};

#define XB_TMO      128
#define XB_XCNT(j)  (256  + 64 * (j))
#define XB_XSUB(j)  (1280 + 64 * (j))
#define XB_XGEN(j)  (2304 + 64 * (j))
#define XB_TOP      3328
#define XB_TOPGEN   3392
#define XCD_BAR_WORDS 3456
#define XB_SPIN_CAP (1u << 18)
__device__ __forceinline__ unsigned xb_ld(unsigned* p)              { return __hip_atomic_load(p, __ATOMIC_RELAXED, __HIP_MEMORY_SCOPE_AGENT); }
__device__ __forceinline__ unsigned xb_add(unsigned* p, unsigned v) { return __hip_atomic_fetch_add(p, v, __ATOMIC_RELAXED, __HIP_MEMORY_SCOPE_AGENT); }
__device__ __forceinline__ unsigned xb_xcc_id() { return (unsigned)__builtin_amdgcn_s_getreg((3 << 11) | 20) & 0xFu; }
#define XB_SPIN(cond, bar) do { unsigned _sp = 0; while (cond) { __builtin_amdgcn_s_sleep(1); \
    if ((++_sp & 255u) == 0u) { if (xb_ld(&(bar)[XB_TMO])) break; if (_sp > XB_SPIN_CAP) { atomicAdd(&(bar)[XB_TMO], 1u); break; } } } } while (0)
struct XcdBarrier { unsigned* bar; unsigned x; volatile LAS unsigned* st; };
__device__ __forceinline__ XcdBarrier xcd_barrier_post(unsigned* bar, volatile LAS unsigned* st) {
    XcdBarrier b; b.bar = bar; b.x = xb_xcc_id(); b.st = st;
    if (threadIdx.x == 0) (void)xb_add(&bar[XB_XCNT(b.x)], 1u);
    return b;
}
__device__ __forceinline__ void xcd_barrier_complete(unsigned* bar, unsigned x, unsigned& nloc, unsigned& nx) {
    const unsigned G = gridDim.x * gridDim.y * gridDim.z;
    unsigned sum, cnt, mine, sp = 0u;
    for (;;) {
        sum = 0u; cnt = 0u; mine = 0u;
#pragma unroll
        for (unsigned j = 0; j < 16; ++j) { const unsigned c = xb_ld(&bar[XB_XCNT(j)]); sum += c; cnt += (c > 0u) ? 1u : 0u; mine = (j == x) ? c : mine; }
        if (sum == G) break;
        __builtin_amdgcn_s_sleep(1);
        if ((++sp & 255u) == 0u) { if (xb_ld(&bar[XB_TMO])) break; if (sp > XB_SPIN_CAP) { atomicAdd(&bar[XB_TMO], 1u); break; } }
    }
    nloc = mine > 0u ? mine : 1u; nx = cnt > 0u ? cnt : 1u;
}
__device__ __forceinline__ void xcd_barrier(const XcdBarrier& b) {
    asm volatile("s_waitcnt vmcnt(0)" ::: "memory");
    __syncthreads();
    if (threadIdx.x == 0) {
        unsigned* bar = b.bar;
        __builtin_amdgcn_s_waitcnt(0);
        unsigned nloc = b.st[0], nx = b.st[1];
        if (nloc == 0u) { xcd_barrier_complete(bar, b.x, nloc, nx); b.st[0] = nloc; b.st[1] = nx; }
        const unsigned old = xb_add(&bar[XB_XSUB(b.x)], 1u);
        const unsigned gen = old / nloc;
        if (old + 1u == (gen + 1u) * nloc) {
            __builtin_amdgcn_fence(__ATOMIC_RELEASE, "agent");
            asm volatile("s_waitcnt vmcnt(0)" ::: "memory");
            const unsigned og = xb_add(&bar[XB_TOP], 1u);
            const unsigned tg = og / nx;
            if (og + 1u == (tg + 1u) * nx) xb_add(&bar[XB_TOPGEN], 1u);
            else XB_SPIN(xb_ld(&bar[XB_TOPGEN]) == tg, bar);
            __builtin_amdgcn_fence(__ATOMIC_ACQUIRE, "agent");
            xb_add(&bar[XB_XGEN(b.x)], 1u);
            asm volatile("s_waitcnt vmcnt(0)" ::: "memory");
        } else {
            XB_SPIN(xb_ld(&bar[XB_XGEN(b.x)]) == gen, bar);
            __builtin_amdgcn_fence(__ATOMIC_ACQUIRE, "agent");
            asm volatile("s_waitcnt vmcnt(0)" ::: "memory");
        }
    }
    __syncthreads();
}

struct Frame {
    LAS unsigned char* lds;
    int tid, lane, wave, vcu, G, gw, NGW;
    const void* const* in;
    float* out; unsigned char* ws;
};
#define F_IN(T, i) ((const T*)F.in[i])
#define x_prompt   F_IN(float, 0)
#define x_sample   F_IN(float, 1)
#define cache_cmp  F_IN(float, 2)
#define cache_sel  F_IN(float, 3)
#define state_win  F_IN(float, 4)
#define page_table F_IN(int, 5)
#define norm_g     F_IN(float, 6)
#define w_in       F_IN(float, 7)
#define ln_v_g     F_IN(float, 8)
#define spatial_w  F_IN(float, 9)
#define spatial_b  F_IN(float, 10)
#define cmp_pe     F_IN(float, 11)
#define cmp_w1     F_IN(float, 12)
#define cmp_b1     F_IN(float, 13)
#define cmp_w2     F_IN(float, 14)
#define cmp_b2     F_IN(float, 15)
#define rel_table  F_IN(float, 16)
#define w_out      F_IN(float, 17)
#define final_g    F_IN(float, 18)
#define WSP(T, off) ((T*)(F.ws + (off)))
#define WinT  WSP(bf16_t, WS_WIN)
#define WoutT WSP(bf16_t, WS_WOUT)
#define W1T   WSP(bf16_t, WS_W1T)
#define W2T   WSP(bf16_t, WS_W2T)
#define SW    WSP(bf16_t, WS_SW)
#define HB    WSP(float, WS_HB)
#define GATES WSP(float, WS_GATES)
#define H     WSP(bf16_t, WS_H)
#define UA    WSP(bf16_t, WS_UA)
#define VG    WSP(bf16_t, WS_VG)
#define Q     WSP(bf16_t, WS_Q)
#define MIX   WSP(bf16_t, WS_MIX)
#define MIXO  WSP(bf16_t, WS_MIXO)
#define KVS   WSP(bf16_t, WS_KVS)
#define KVW   WSP(bf16_t, WS_KVW)
#define AC    WSP(bf16_t, WS_AC)
#define HC    WSP(bf16_t, WS_HC)
#define KC    WSP(bf16_t, WS_KC)
#define KCS   WSP(bf16_t, WS_KCS)
#define HCS   WSP(bf16_t, WS_HCS)
#define ACS   WSP(bf16_t, WS_ACS)

__device__ const unsigned char T5_BUCKET[128] = {
    0, 1, 2, 3, 4, 5, 6, 7, 8, 9, 10, 11, 12, 13, 14, 15, 16, 16, 16, 17, 17, 18, 18, 18, 19, 19, 19, 20, 20, 20, 20, 21, 21, 21, 21, 22, 22, 22, 22, 22, 23, 23, 23, 23, 23, 23, 24, 24, 24, 24, 24, 24,
    25, 25, 25, 25, 25, 25, 25, 26, 26, 26, 26, 26, 26, 26, 26, 27, 27, 27, 27, 27, 27, 27, 27, 27, 27, 28, 28, 28, 28, 28, 28, 28, 28, 28, 28, 29, 29, 29, 29, 29, 29, 29, 29, 29, 29, 29, 29,
    30, 30, 30, 30, 30, 30, 30, 30, 30, 30, 30, 30, 30, 30, 31, 31, 31, 31, 31, 31, 31, 31, 31, 31, 31, 31, 31, 31, 31};

__device__ __forceinline__ void transpose_item(const float* W, int ldw, int K, bf16_t* WT, int k0, int c0, int r0, int cvalid, LAS float* scr, int lane) {
#pragma unroll 8
    for (int i = 0; i < 32; ++i) { const int kk = 2 * i + (lane >> 5), cc = lane & 31; scr[kk * 33 + cc] = (cc < cvalid) ? W[(size_t)(k0 + kk) * ldw + c0 + cc] : 0.f; }
    LDS_WAIT(); asm volatile("" ::: "memory");
    const int c = lane & 7;
#pragma unroll
    for (int j = 0; j < 4; ++j) { const int n = (lane >> 3) + 8 * j; const LAS float* s = scr + (8 * c) * 33 + n;
        u32x4 o; o.x = pk2(s[0 * 33], s[1 * 33]); o.y = pk2(s[2 * 33], s[3 * 33]); o.z = pk2(s[4 * 33], s[5 * 33]); o.w = pk2(s[6 * 33], s[7 * 33]);
        *(u32x4*)(WT + (size_t)(r0 + n) * K + k0 + 8 * c) = o; }
    LDS_WAIT(); asm volatile("" ::: "memory");
}

__device__ __forceinline__ void convert_rows(Frame& F, int m) {
    const int lane = F.lane, b = m >> 3, g = (m >> 2) & 1, nq = m & 3;
    const int nci = (nq == 3) ? 256 : 257;
    for (int c0 = F.wave; c0 < nci; c0 += 16) {
        const int c1 = (c0 + 8 < nci) ? c0 + 8 : c0;
        const int n0 = 256 * nq + c0, n1 = 256 * nq + c1;
        const int ph0 = page_table[b * NPAGES + (n0 >> 3)], ph1 = page_table[b * NPAGES + (n1 >> 3)];
        const float* s0 = cache_cmp + ((size_t)ph0 * PAGE + (n0 & 7) * 16) * 256 + g * 64;
        const float* s1 = cache_cmp + ((size_t)ph1 * PAGE + (n1 & 7) * 16) * 256 + g * 64;
        bf16_t* d0 = ACS + ((size_t)((b * 2 + g) * NCS + n0)) * 1024;
        bf16_t* d1 = ACS + ((size_t)((b * 2 + g) * NCS + n1)) * 1024;
        f32x4 v0[8], v1[8];
#pragma unroll
        for (int i = 0; i < 8; ++i) { const int idx = i * 64 + lane, kv = idx >> 8, l = (idx >> 4) & 15, d4 = idx & 15; const size_t so = (size_t)l * 256 + kv * 128 + d4 * 4;
            v0[i] = __builtin_nontemporal_load((const f32x4*)(s0 + so)); v1[i] = __builtin_nontemporal_load((const f32x4*)(s1 + so)); }
#pragma unroll
        for (int i = 0; i < 8; ++i) { const int idx = i * 64 + lane, kv = idx >> 8, l = (idx >> 4) & 15, d4 = idx & 15; const size_t dof = (size_t)kv * DB * 2 * NCS * 1024 + l * 64 + d4 * 4;
            u32x2 o; o.x = pk2(v0[i][0], v0[i][1]); o.y = pk2(v0[i][2], v0[i][3]); *(u32x2*)(d0 + dof) = o;
            u32x2 p; p.x = pk2(v1[i][0], v1[i][1]); p.y = pk2(v1[i][2], v1[i][3]); *(u32x2*)(d1 + dof) = p; }
    }
}

__device__ __forceinline__ void p0_prologue(Frame& F) {
    LAS float* scr = (LAS float*)(F.lds + F.wave * 16384);
    const int gw = F.gw, NGW = F.NGW, lane = F.lane;
    constexpr int I_IN = 16 * (NPAD / 32), I_OUT = 16 * 32, I_W1 = 2 * 32 * 8, I_W2 = 2 * 4 * 8;
    constexpr int NITEMS = I_IN + I_OUT + I_W1 + I_W2;
    for (int it = gw; it < NITEMS; it += NGW) {
        int r = it;
        if (r < I_IN) { const int kb = r / (NPAD / 32), nb = r % (NPAD / 32), r0 = nb * 32; int c0, cv;
            if (r0 < 2816) { c0 = r0; cv = 32; } else if (r0 < 3328) { c0 = r0 + 24; cv = 32; } else if (r0 == 3328) { c0 = 2816; cv = 24; } else { c0 = 0; cv = 0; }
            transpose_item(w_in, D_IN, DM, WinT, kb * 64, c0, r0, cv, scr, lane); continue; }
        r -= I_IN;
        if (r < I_OUT) { transpose_item(w_out, DM, DM, WoutT, (r / 32) * 64, (r % 32) * 32, (r % 32) * 32, 32, scr, lane); continue; }
        r -= I_OUT;
        if (r < I_W1) { const int kv = r / 256, q = r % 256;
            transpose_item(cmp_w1 + (size_t)kv * 2048 * 256, 256, 2048, W1T + (size_t)kv * 256 * 2048, (q / 8) * 64, (q % 8) * 32, (q % 8) * 32, 32, scr, lane); continue; }
        r -= I_W1;
        { const int kv = r / 32, q = r % 32, nb = q % 8;
          transpose_item(cmp_w2 + (size_t)kv * 256 * 64, 64, 256, W2T + (size_t)kv * 256 * 256, (q / 8) * 64, (nb < 2 ? nb * 32 : 0), nb * 32, (nb < 2 ? 32 : 0), scr, lane); }
    }
    for (int i = gw * 64 + lane; i < 8 * 128 * 128; i += NGW * 64) { const int s = i & 127, t = (i >> 7) & 127; SW[i] = (bf16_t)f2bf(s <= t ? spatial_w[i] : 0.f); }
    if (gw < 512) { const int o = gw, kv = o >> 8, h = o & 255; const float* w = cmp_w1 + (size_t)kv * 2048 * 256 + h; const float* pe = cmp_pe + kv * 2048; float a = 0.f;
#pragma unroll 8
        for (int k = lane; k < 2048; k += 64) a += pe[k] * w[(size_t)k * 256];
        a = wave_sum(a);
        if (lane == 0) HB[o] = a + cmp_b1[o]; }
    for (int m = gw; m < MT; m += 2 * NGW) {
        const int m2 = (m + NGW < MT) ? m + NGW : m;
        const float* xa = (m < MP) ? x_prompt + (size_t)m * DM : x_sample + (size_t)(m - MP) * DM;
        const float* xb = (m2 < MP) ? x_prompt + (size_t)m2 * DM : x_sample + (size_t)(m2 - MP) * DM;
        f32x4 va[4], vb[4]; float sa = 0.f, sb = 0.f;
#pragma unroll
        for (int j = 0; j < 4; ++j) { va[j] = *(const f32x4*)(xa + 256 * j + 4 * lane); vb[j] = *(const f32x4*)(xb + 256 * j + 4 * lane); }
#pragma unroll
        for (int j = 0; j < 4; ++j) { sa += (va[j][0] * va[j][0] + va[j][1] * va[j][1]) + (va[j][2] * va[j][2] + va[j][3] * va[j][3]);
            sb += (vb[j][0] * vb[j][0] + vb[j][1] * vb[j][1]) + (vb[j][2] * vb[j][2] + vb[j][3] * vb[j][3]); }
        const float ra = 1.f / sqrtf(wave_sum(sa) * (1.f / DM) + 1e-6f), rb = 1.f / sqrtf(wave_sum(sb) * (1.f / DM) + 1e-6f);
#pragma unroll
        for (int j = 0; j < 4; ++j) { const f32x4 g = *(const f32x4*)(norm_g + 256 * j + 4 * lane);
            u32x2 o; o.x = pk2(va[j][0] * ra * g[0], va[j][1] * ra * g[1]); o.y = pk2(va[j][2] * ra * g[2], va[j][3] * ra * g[3]);
            *(u32x2*)(H + (size_t)m * DM + 256 * j + 4 * lane) = o;
            u32x2 p; p.x = pk2(vb[j][0] * rb * g[0], vb[j][1] * rb * g[1]); p.y = pk2(vb[j][2] * rb * g[2], vb[j][3] * rb * g[3]);
            *(u32x2*)(H + (size_t)m2 * DM + 256 * j + 4 * lane) = p; }
    }
    for (int i = gw * 64 + lane; i < DB * 504 * 64; i += NGW * 64) { const int b = i / (504 * 64), r = i % (504 * 64);
        *(f32x4*)(F.out + O_WS + (size_t)b * 512 * 256 + (size_t)r * 4) = *(const f32x4*)(state_win + (size_t)b * 512 * 256 + 8 * 256 + (size_t)r * 4); }
}

__device__ __forceinline__ float oct_sum(float v) {
    v += __builtin_bit_cast(float, __builtin_amdgcn_update_dpp(0, __builtin_bit_cast(int, v), 0xB1, 0xF, 0xF, true));
    v += __builtin_bit_cast(float, __builtin_amdgcn_update_dpp(0, __builtin_bit_cast(int, v), 0x4E, 0xF, 0xF, true));
    v += __builtin_bit_cast(float, __builtin_amdgcn_update_dpp(0, __builtin_bit_cast(int, v), 0x141, 0xF, 0xF, true));
    return v;
}
__device__ __forceinline__ s16x4 vtr(const LAS char* p) { return __builtin_bit_cast(s16x4, __builtin_amdgcn_ds_read_tr16_b64_v4i16((LAS s16x4*)p)); }

__device__ __forceinline__ void spatial_task(Frame& F, int chunk, int g, LAS char* vt) {
    const int lane = F.lane, h = lane >> 4, i16 = lane & 15;
    const size_t r0 = (size_t)chunk * 128;
    { const int ch = lane & 7;
      const f32x4 g0 = *(const f32x4*)(ln_v_g + g * 64 + ch * 8), g1 = *(const f32x4*)(ln_v_g + g * 64 + ch * 8 + 4);
#pragma unroll 4
      for (int i = 0; i < 16; ++i) { const int t = i * 8 + (lane >> 3);
          const u32x4 w = *(const u32x4*)(VG + (r0 + t) * 512 + g * 64 + ch * 8);
          float v[8] = {bflo(w.x), bfhi(w.x), bflo(w.y), bfhi(w.y), bflo(w.z), bfhi(w.z), bflo(w.w), bfhi(w.w)};
          float s = 0.f;
#pragma unroll
          for (int e = 0; e < 8; ++e) s += v[e];
          s = oct_sum(s);
          const float mu = s * (1.f / 64.f); float q = 0.f;
#pragma unroll
          for (int e = 0; e < 8; ++e) { v[e] -= mu; q += v[e] * v[e]; }
          q = oct_sum(q);
          const float rs = 1.f / sqrtf(q * (1.f / 64.f) + 1e-5f);
          u32x2 a, b; a.x = pk2(v[0] * rs * g0[0], v[1] * rs * g0[1]); a.y = pk2(v[2] * rs * g0[2], v[3] * rs * g0[3]);
          b.x = pk2(v[4] * rs * g1[0], v[5] * rs * g1[1]); b.y = pk2(v[6] * rs * g1[2], v[7] * rs * g1[3]);
          *(LAS u32x2*)(vt + t * SP_PITCH + ch * 16) = a; *(LAS u32x2*)(vt + t * SP_PITCH + ch * 16 + 8) = b; }
    }
    const bf16_t* Wg = SW + (size_t)g * 128 * 128;
    const LAS char* vb = vt + (8 * h + (i16 >> 2)) * SP_PITCH + (i16 & 3) * 8;
    f32x4 acc[8][4];
#pragma unroll
    for (int mt = 0; mt < 8; ++mt)
#pragma unroll
        for (int n = 0; n < 4; ++n) acc[mt][n] = (f32x4){0.f, 0.f, 0.f, 0.f};
#pragma unroll
    for (int ks = 0; ks < 4; ++ks) {
        bf16x8 wf[8];
#pragma unroll
        for (int mt = 2 * ks; mt < 8; ++mt) wf[mt] = *(const bf16x8*)(Wg + (size_t)(16 * mt + i16) * 128 + 32 * ks + 8 * h);
        bf16x8 vaf[4];
#pragma unroll
        for (int n = 0; n < 4; ++n) { const s16x4 lo = vtr(vb + (32 * ks) * SP_PITCH + n * 32), hi = vtr(vb + (32 * ks + 4) * SP_PITCH + n * 32);
            vaf[n] = (bf16x8){lo[0], lo[1], lo[2], lo[3], hi[0], hi[1], hi[2], hi[3]}; }
#pragma unroll
        for (int mt = 2 * ks; mt < 8; ++mt)
#pragma unroll
            for (int n = 0; n < 4; ++n) acc[mt][n] = __builtin_amdgcn_mfma_f32_16x16x32_bf16(vaf[n], wf[mt], acc[mt][n], 0, 0, 0);
    }
#pragma unroll
    for (int mt = 0; mt < 8; ++mt) { const int t = 16 * mt + i16; const float sb = spatial_b[g * 128 + t];
#pragma unroll
        for (int n = 0; n < 4; ++n) {
            const u32x2 uw = *(const u32x2*)(UA + (r0 + t) * 512 + g * 64 + 16 * n + 4 * h);
            const size_t mo = (r0 + t) * 1024 + g * 64 + 16 * n + 4 * h;
            const u32x2 zw = *(const u32x2*)(MIX + mo);
            u32x2 o; o.x = pk2(bflo(uw.x) * (acc[mt][n][0] + sb) * bflo(zw.x), bfhi(uw.x) * (acc[mt][n][1] + sb) * bfhi(zw.x));
            o.y = pk2(bflo(uw.y) * (acc[mt][n][2] + sb) * bflo(zw.y), bfhi(uw.y) * (acc[mt][n][3] + sb) * bfhi(zw.y));
            *(u32x2*)(MIXO + mo) = o; }
        asm volatile("" ::: "memory"); }
}
__device__ __forceinline__ void spatial_sample_task(Frame& F, int b, int g) {
    const int d = F.lane; const size_t r0 = (size_t)MP + b * 8;
    float va[8];
    const float lg = ln_v_g[g * 64 + d];
#pragma unroll
    for (int s = 0; s < 8; ++s) { const float v = bf2f(VG[(r0 + s) * 512 + g * 64 + d]); const float mu = wave_sum(v) * (1.f / 64.f); const float dv = v - mu;
        const float var = wave_sum(dv * dv) * (1.f / 64.f); va[s] = dv * (1.f / sqrtf(var + 1e-5f)) * lg;
        F.out[O_CV + ((size_t)b * 8 + s) * 512 + g * 64 + d] = va[s]; }
#pragma unroll
    for (int t = 0; t < 8; ++t) { float a = spatial_b[g * 128 + t];
#pragma unroll
        for (int s = 0; s <= t; ++s) a += spatial_w[((size_t)g * 128 + t) * 128 + s] * va[s];
        const float ua = bf2f(UA[(r0 + t) * 512 + g * 64 + d]);
        const size_t mo = (r0 + t) * 1024 + g * 64 + d;
        MIXO[mo] = (bf16_t)f2bf(ua * a * bf2f(MIX[mo])); }
}

struct SrcBf16 { const bf16_t* k; const bf16_t* v; int pitch; };
struct SrcF32 { const float* k; const float* v; int kmax; };

__device__ __forceinline__ void load_k(bf16x8 (&kf)[4][2], const SrcBf16& s, int lane) {
#pragma unroll
    for (int t = 0; t < 4; ++t)
#pragma unroll
        for (int ks = 0; ks < 2; ++ks) kf[t][ks] = *(const bf16x8*)(s.k + (size_t)(16 * t + (lane & 15)) * s.pitch + 32 * ks + 8 * (lane >> 4));
}
__device__ __forceinline__ void stage_v(LAS char* vs, const SrcBf16& s, int lane) {
#pragma unroll
    for (int c = 0; c < 8; ++c) { const int idx = c * 64 + lane, key = idx >> 3, ch = idx & 7;
        const u32x4 w = *(const u32x4*)(s.v + (size_t)key * s.pitch + ch * 8);
        *(LAS u32x4*)(vs + key * AW_VP + ch * 16) = w; }
}
__device__ __forceinline__ bf16x8 cvt8(const f32x4& a, const f32x4& b) {
    u32x4 w; w.x = pk2(a[0], a[1]); w.y = pk2(a[2], a[3]); w.z = pk2(b[0], b[1]); w.w = pk2(b[2], b[3]); return __builtin_bit_cast(bf16x8, w);
}
__device__ __forceinline__ void load_k(bf16x8 (&kf)[4][2], const SrcF32& s, int lane) {
#pragma unroll
    for (int t = 0; t < 4; ++t) { int kk = 16 * t + (lane & 15); kk = kk < s.kmax ? kk : s.kmax;
#pragma unroll
        for (int ks = 0; ks < 2; ++ks) { const float* p = s.k + (size_t)kk * 256 + 32 * ks + 8 * (lane >> 4); kf[t][ks] = cvt8(*(const f32x4*)p, *(const f32x4*)(p + 4)); } }
}
__device__ __forceinline__ void stage_v(LAS char* vs, const SrcF32& s, int lane) {
#pragma unroll
    for (int c = 0; c < 8; ++c) { const int idx = c * 64 + lane, key = idx >> 3, ch = idx & 7; const int kk = key < s.kmax ? key : s.kmax;
        const float* p = s.v + (size_t)kk * 256 + ch * 8;
        *(LAS bf16x8*)(vs + key * AW_VP + ch * 16) = cvt8(*(const f32x4*)p, *(const f32x4*)(p + 4));
        if (c == 3) __builtin_amdgcn_sched_barrier(0); }
}
typedef f32x4 Sc4[4];
template <int STRIDE>
__device__ __forceinline__ void qk_scores(Sc4& acc, const bf16x8 (&kf)[4][2], const bf16x8 (&qf)[2], int D0, unsigned LIM, const LAS float* tbh, const LAS f32x4* t2h, int h, float mref, float bfar) {
    const bool far = __all(D0 < 0 || (D0 - 63 * STRIDE >= 128 && (unsigned)D0 < LIM));
    const float c0 = far ? (D0 < 0 ? -INFINITY : bfar - mref) : -mref;
    const f32x4 ci = {c0, c0, c0, c0};
    if (STRIDE == 1 && !far && __all(D0 < (int)LIM)) {
#pragma unroll
        for (int t = 0; t < 4; ++t) { int e = D0 - 16 * t - 4 * h; e = e < -1 ? -1 : e; e = e > 131 ? 131 : e;
            const f32x4 cz = t2h[e];
            acc[t] = cz - mref; }
#pragma unroll
        for (int t = 0; t < 4; ++t) { acc[t] = __builtin_amdgcn_mfma_f32_16x16x32_bf16(kf[t][0], qf[0], acc[t], 0, 0, 0);
            acc[t] = __builtin_amdgcn_mfma_f32_16x16x32_bf16(kf[t][1], qf[1], acc[t], 0, 0, 0); }
        return;
    }
    if (STRIDE == 1 && !far && __all(D0 < 0 || D0 - 63 >= 128)) {
#pragma unroll
        for (int t = 0; t < 4; ++t) { int x = D0 - 16 * t - 4 * h - (int)LIM; x = x < -1 ? -1 : x; x = x > 3 ? 3 : x; x = D0 < 0 ? 3 : x;
            const f32x4 cz = t2h[133 + x];
            acc[t] = cz - mref; }
#pragma unroll
        for (int t = 0; t < 4; ++t) { acc[t] = __builtin_amdgcn_mfma_f32_16x16x32_bf16(kf[t][0], qf[0], acc[t], 0, 0, 0);
            acc[t] = __builtin_amdgcn_mfma_f32_16x16x32_bf16(kf[t][1], qf[1], acc[t], 0, 0, 0); }
        return;
    }
#pragma unroll
    for (int t = 0; t < 4; ++t) { acc[t] = __builtin_amdgcn_mfma_f32_16x16x32_bf16(kf[t][0], qf[0], ci, 0, 0, 0);
        acc[t] = __builtin_amdgcn_mfma_f32_16x16x32_bf16(kf[t][1], qf[1], acc[t], 0, 0, 0); }
    if (!far) {
#pragma unroll
        for (int t = 0; t < 4; ++t)
#pragma unroll
            for (int r = 0; r < 4; ++r) { const int kk = 16 * t + 4 * h + r; const int dist = D0 - STRIDE * kk;
                int dc = dist < 0 ? 0 : dist; dc = dc > 128 ? 128 : dc;
                const float v = acc[t][r] + tbh[dc * 8];
                acc[t][r] = ((unsigned)dist < LIM) ? v : -INFINITY; }
    }
}
__device__ __forceinline__ float quad_sum(float v) {
    v += __builtin_bit_cast(float, __builtin_amdgcn_update_dpp(0, __builtin_bit_cast(int, v), 0xB1, 0xF, 0xF, true));
    v += __builtin_bit_cast(float, __builtin_amdgcn_update_dpp(0, __builtin_bit_cast(int, v), 0x4E, 0xF, 0xF, true));
    return v;
}
__device__ __forceinline__ float xrow_max(float m) {
    auto a = __builtin_amdgcn_permlane16_swap(__float_as_uint(m), __float_as_uint(m), false, false); m = fmaxf(__uint_as_float(a[0]), __uint_as_float(a[1]));
    auto c = __builtin_amdgcn_permlane32_swap(__float_as_uint(m), __float_as_uint(m), false, false); return fmaxf(__uint_as_float(c[0]), __uint_as_float(c[1]));
}
__device__ __forceinline__ float xrow_sum(float m) {
    auto a = __builtin_amdgcn_permlane16_swap(__float_as_uint(m), __float_as_uint(m), false, false); m = __uint_as_float(a[0]) + __uint_as_float(a[1]);
    auto c = __builtin_amdgcn_permlane32_swap(__float_as_uint(m), __float_as_uint(m), false, false); return __uint_as_float(c[0]) + __uint_as_float(c[1]);
}
__device__ __forceinline__ float max3f(float a, float b, float c) { float r; asm("v_max3_f32 %0, %1, %2, %3" : "=v"(r) : "v"(a), "v"(b), "v"(c)); return r; }
__device__ __forceinline__ float lane_max16(Sc4& s) {
    asm volatile("s_nop 7\n\ts_nop 3" : "+v"(s[0]), "+v"(s[1]), "+v"(s[2]), "+v"(s[3]));
    float a = max3f(s[0][0], s[0][1], s[0][2]), b = max3f(s[0][3], s[1][0], s[1][1]);
    a = max3f(a, s[1][2], s[1][3]); b = max3f(b, s[2][0], s[2][1]); a = max3f(a, s[2][2], s[2][3]); b = max3f(b, s[3][0], s[3][1]); a = max3f(a, s[3][2], s[3][3]);
    return max3f(a, b, b);
}
__device__ __forceinline__ float mref_of(float m) { return (m == -INFINITY) ? 0.f : m; }
struct SoftSt { float m; f32x4 l; f32x4 o[4]; };
__device__ __forceinline__ void soft_init(SoftSt& st) { st.m = -INFINITY; st.l = (f32x4){0.f, 0.f, 0.f, 0.f};
#pragma unroll
    for (int dt = 0; dt < 4; ++dt) st.o[dt] = (f32x4){0.f, 0.f, 0.f, 0.f}; }
__device__ __forceinline__ void pack_p(bf16x8 (&pb)[2], const Sc4& p) {
#pragma unroll
    for (int s = 0; s < 2; ++s) { u32x4 w; w.x = pk2(p[2 * s][0], p[2 * s][1]); w.y = pk2(p[2 * s][2], p[2 * s][3]); w.z = pk2(p[2 * s + 1][0], p[2 * s + 1][1]); w.w = pk2(p[2 * s + 1][2], p[2 * s + 1][3]); pb[s] = __builtin_bit_cast(bf16x8, w); }
}
__device__ __forceinline__ void exp4(Sc4& s) {
#pragma unroll
    for (int t = 0; t < 4; ++t)
#pragma unroll
        for (int r = 0; r < 4; ++r) s[t][r] = __builtin_amdgcn_exp2f(s[t][r]);
}
__device__ __forceinline__ void sum_acc(f32x4& l, const bf16x8 (&pb)[2]) {
    const bf16x8 ones = {(short)0x3F80, (short)0x3F80, (short)0x3F80, (short)0x3F80, (short)0x3F80, (short)0x3F80, (short)0x3F80, (short)0x3F80};
    l = __builtin_amdgcn_mfma_f32_16x16x32_bf16(ones, pb[0], l, 0, 0, 0);
    l = __builtin_amdgcn_mfma_f32_16x16x32_bf16(ones, pb[1], l, 0, 0, 0);
}
__device__ __forceinline__ void load_vf(bf16x8 (&vf)[2][4], const LAS char* vs, int lane) {
    const int h = lane >> 4, i16 = lane & 15;
    const LAS char* vb = vs + (4 * h + (i16 >> 2)) * AW_VP + (i16 & 3) * 8;
#pragma unroll
    for (int s = 0; s < 2; ++s)
#pragma unroll
        for (int dt = 0; dt < 4; ++dt) {
            const s16x4 lo = vtr(vb + (32 * s) * AW_VP + dt * 32), hi = vtr(vb + (32 * s + 16) * AW_VP + dt * 32);
            vf[s][dt] = (bf16x8){lo[0], lo[1], lo[2], lo[3], hi[0], hi[1], hi[2], hi[3]};
        }
}
__device__ __forceinline__ void pv_acc(f32x4 (&o)[4], const bf16x8 (&pb)[2], const bf16x8 (&vf)[2][4]) {
#pragma unroll
    for (int s = 0; s < 2; ++s)
#pragma unroll
        for (int dt = 0; dt < 4; ++dt) o[dt] = __builtin_amdgcn_mfma_f32_16x16x32_bf16(vf[s][dt], pb[s], o[dt], 0, 0, 0);
}
template <bool WITH_O>
__device__ __forceinline__ void max_update(Sc4& s, SoftSt& st) {
    const float lm = lane_max16(s);
    const bool first = (st.m == -INFINITY);
    if (__any(lm > 8.f || (first && lm > -INFINITY))) {
        const float mb = xrow_max(lm);
        const float delta = first ? ((mb == -INFINITY) ? 0.f : mb) : fmaxf(mb, 0.f);
        st.m = first ? mb : st.m + delta;
        const float alpha = __builtin_amdgcn_exp2f(-delta);
        st.l = st.l * alpha;
        if (WITH_O) {
#pragma unroll
            for (int dt = 0; dt < 4; ++dt) st.o[dt] = st.o[dt] * alpha; }
#pragma unroll
        for (int t = 0; t < 4; ++t) s[t] = s[t] - delta;
    }
}
__device__ __forceinline__ void online_step(Sc4& s, SoftSt& st, const bf16x8 (&vf)[2][4]) {
    max_update<true>(s, st);
    exp4(s);
    bf16x8 pb[2]; pack_p(pb, s);
    sum_acc(st.l, pb);
    pv_acc(st.o, pb, vf);
}
__device__ __forceinline__ void stats_step(Sc4& s, SoftSt& st) {
    max_update<false>(s, st);
    exp4(s);
    const float a0 = (s[0][0] + s[0][1]) + (s[0][2] + s[0][3]), a1 = (s[1][0] + s[1][1]) + (s[1][2] + s[1][3]), a2 = (s[2][0] + s[2][1]) + (s[2][2] + s[2][3]), a3 = (s[3][0] + s[3][1]) + (s[3][2] + s[3][3]);
    const float t = xrow_sum((a0 + a1) + (a2 + a3));
    st.l = st.l + (f32x4){t, t, t, t};
}

__device__ __forceinline__ void attn_bias_table(Frame& F, LAS float* tb);
constexpr int CP_BUFSZ = 19456, CP_V = 9216, CP_KP = 144;
constexpr int CP_IMPG = 2 * CP_BUFSZ;
constexpr int CP_IMP = 4 * CP_BUFSZ, CP_IMPN = 132, CP_MSK = 7 * 16384, CP_TASK = CP_MSK + 1024;
static_assert(CP_IMP + 64 * CP_IMPN * 4 <= CP_MSK, "attention LDS map");
constexpr int LDS_XCH = LDS_TB + 4352;
constexpr int LDS_T2 = LDS_XCH + 3072, T2N = 138;
static_assert(CP_TASK + 64 <= LDS_TB && LDS_T2 + 8 * T2N * 16 <= LDS_MISC, "attention LDS map");

__device__ __forceinline__ void load_k_lds(bf16x8 (&kf)[4][2], const LAS char* kb, int lane) {
#pragma unroll
    for (int t = 0; t < 4; ++t)
#pragma unroll
        for (int ks = 0; ks < 2; ++ks) kf[t][ks] = *(const LAS bf16x8*)(kb + (16 * t + (lane & 15)) * CP_KP + ks * 64 + (lane >> 4) * 16);
}
template <int NW64>
__device__ __forceinline__ void topk_masks(const LAS float* iq, const LAS float* ip, int cur, LAS unsigned long long* mq, int lane) {
    unsigned key[NW64];
#pragma unroll
    for (int u = 0; u < NW64; ++u) { const int jj = 64 * u + lane; const bool cand = (jj >= 1 && jj <= cur - 2);
        float v = 0.f; if (cand) { v = iq[jj]; if (ip) v += ip[jj]; }
        key[u] = cand ? __float_as_uint(v) : 0u; }
    unsigned long long selm[NW64];
    if (cur >= 16) {
        unsigned T = 0u;
        for (int bit = 31; bit >= 0; --bit) { const unsigned trial = T | (1u << bit); int cnt = 0;
#pragma unroll
            for (int u = 0; u < NW64; ++u) cnt += __builtin_popcountll(__ballot(key[u] >= trial));
            if (cnt >= 13) T = trial; }
        int c = 0;
#pragma unroll
        for (int u = 0; u < NW64; ++u) c += __builtin_popcountll(__ballot(key[u] > T));
        int needed = 13 - c, before = 0;
#pragma unroll
        for (int u = 0; u < NW64; ++u) { const int jj = 64 * u + lane;
            const bool cand = (jj >= 1 && jj <= cur - 2);
            const unsigned long long eqm = __ballot(cand && key[u] == T);
            const int pos = before + __builtin_popcountll(eqm & ((1ull << lane) - 1ull));
            const bool pick = cand && (key[u] > T || (key[u] == T && pos < needed));
            before += __builtin_popcountll(eqm);
            selm[u] = __ballot(pick || jj == 0 || (jj >= cur - 1 && jj <= cur)); }
    } else {
#pragma unroll
        for (int u = 0; u < NW64; ++u) selm[u] = __ballot(64 * u + lane <= cur);
    }
    if (lane == 0) {
#pragma unroll
        for (int u = 0; u < NW64; ++u) mq[u] = selm[u]; }
}
__device__ __forceinline__ unsigned long long uniform64(unsigned long long x) {
    return ((unsigned long long)__builtin_amdgcn_readfirstlane((unsigned)(x >> 32)) << 32) | (unsigned)__builtin_amdgcn_readfirstlane((unsigned)x);
}

constexpr int SEL_SLOT = 16384, SEL_NS = 7;
static_assert(SEL_NS * SEL_SLOT <= CP_MSK && 2 * SEL_SLOT <= CP_IMPG, "selected-branch ring");
__device__ __forceinline__ void sel_stage(LAS char* slot, const bf16_t* blk, int lane) {
    const int r8 = lane >> 3, pc = lane & 7;
#pragma unroll
    for (int i = 0; i < 8; ++i) {
        const int c = pc ^ ((4 * (i & 1)) | (r8 >> 1));
        const bf16_t* gp = blk + (size_t)(8 * i + r8) * 256 + c * 8;
        __builtin_amdgcn_global_load_lds((const unsigned*)gp, (LAS unsigned*)(slot + i * 1024), 16, 0, 0);
        __builtin_amdgcn_global_load_lds((const unsigned*)(gp + 128), (LAS unsigned*)(slot + 8192 + i * 1024), 16, 0, 0);
    }
}
__device__ __forceinline__ void load_k_sw(bf16x8 (&kf)[4][2], const LAS char* slot, int lane) {
    const int j16 = lane & 15, h = lane >> 4, sw = j16 >> 1;
#pragma unroll
    for (int t = 0; t < 4; ++t)
#pragma unroll
        for (int ks = 0; ks < 2; ++ks) kf[t][ks] = *(const LAS bf16x8*)(slot + (16 * t + j16) * 128 + (((4 * ks + h) ^ sw) << 4));
}
__device__ __forceinline__ void load_vf_sw(bf16x8 (&vf)[2][4], const LAS char* vs, int lane) {
    const int h = lane >> 4, i16 = lane & 15, sw = (2 * h + (i16 >> 3)) & 7;
    const LAS char* vb = vs + (4 * h + (i16 >> 2)) * 128 + (i16 & 1) * 8;
#pragma unroll
    for (int s = 0; s < 2; ++s)
#pragma unroll
        for (int dt = 0; dt < 4; ++dt) { const int po = ((2 * dt + ((i16 >> 1) & 1)) ^ sw) << 4;
            const s16x4 lo = vtr(vb + (32 * s) * 128 + po), hi = vtr(vb + (32 * s + 16) * 128 + po);
            vf[s][dt] = (bf16x8){lo[0], lo[1], lo[2], lo[3], hi[0], hi[1], hi[2], hi[3]};
        }
}
__device__ __forceinline__ void lds_spin_ge(const volatile LAS unsigned* p, unsigned want) {
    unsigned sp = 0;
    while ((unsigned)__builtin_amdgcn_readfirstlane((int)*p) < want) { __builtin_amdgcn_s_sleep(1); if (++sp > (1u << 20)) break; }
    asm volatile("" ::: "memory");
}
__device__ __forceinline__ void coop_prompt_task(Frame& F, int b, int g, int qblk, const LAS float* tb, const int var) {
    int tid = threadIdx.x; asm volatile("" : "+v"(tid));
    const int lane = tid & 63, w = F.wave, h = lane >> 4, j = lane & 15, qq = j >> 2, r = j & 3;
    const int head = g * 4 + r, q0 = 64 * qblk;
    const LAS float* tbh = tb + head;
    const float bfar = tbh[128 * 8];
    LAS char* lds = (LAS char*)F.lds;
    const LAS f32x4* t2h = (const LAS f32x4*)(lds + LDS_T2) + head * T2N + 1;
    LAS float* imp = (LAS float*)(lds + CP_IMP);
    LAS unsigned long long* msk = (LAS unsigned long long*)(lds + CP_MSK);
    int myq[2]; bf16x8 qf[2][2];
#pragma unroll
    for (int s = 0; s < 2; ++s) { myq[s] = q0 + 8 * w + 4 * s + qq;
#pragma unroll
        for (int ks = 0; ks < 2; ++ks) qf[s][ks] = *(const bf16x8*)(Q + ((size_t)b * SEQ + myq[s]) * 512 + head * 64 + 32 * ks + 8 * h); }
#define MYROW(s) ((size_t)b * SEQ + myq[s])
#define RBASE(s) (WSP(float, WS_DBG) + MYROW(s) * 512 + head * 64 + 4 * h)
#define GATE(s, br) (GATES[MYROW(s) * 24 + head * 3 + (br)])
    const int skey = tid >> 3, sch = tid & 7;
    __syncthreads();
    volatile LAS unsigned* rdy = (volatile LAS unsigned*)(lds + LDS_XCH); LAS unsigned* dn = (LAS unsigned*)(lds + LDS_XCH) + 128;
    if (tid < 256) rdy[tid] = 0u;
    int step = 0;
    bf16x8 kf[4][2]; Sc4 sc; u32x4 rk, rv;
    SoftSt st[2];
    const bf16_t* kc = KC + ((size_t)(b * 2 + g) * 512) * 64; const bf16_t* vc = kc + (size_t)NB * 2 * 512 * 64;
    const int ncb = ((4 * qblk + 3) >> 6) + 1;
    soft_init(st[0]); soft_init(st[1]);
    rk = *(const u32x4*)(kc + (size_t)skey * 64 + sch * 8);
    rv = *(const u32x4*)(vc + (size_t)skey * 64 + sch * 8);
    for (int cb = 0; cb < ncb; ++cb) {
        LAS char* buf = lds + (step & 1) * CP_BUFSZ; ++step;
        *(LAS u32x4*)(buf + skey * CP_KP + sch * 16) = rk;
        rk = *(const u32x4*)(kc + (size_t)(64 * (cb + 1 < ncb ? cb + 1 : 0) + skey) * 64 + sch * 8);
        LDS_BARRIER();
        load_k_lds(kf, buf, lane);
#pragma unroll
        for (int s = 0; s < 2; ++s) {
            qk_scores<16>(sc, kf, qf[s], myq[s] - 31 - 1024 * cb, 0x7fffffffu, tbh, t2h, h, mref_of(st[s].m), bfar);
            stats_step(sc, st[s]);
        }
    }
    {
        float mr2[2];
#pragma unroll
        for (int s = 0; s < 2; ++s) { const float l = st[s].l[0]; mr2[s] = (l > 0.f) ? st[s].m + __builtin_amdgcn_logf(l) : 0.f;
#pragma unroll
            for (int dt = 0; dt < 4; ++dt) st[s].o[dt] = (f32x4){0.f, 0.f, 0.f, 0.f}; }
        const bf16_t* kw0 = KVW + ((size_t)b * SEQ + skey) * 256 + g * 64 + sch * 8 + (size_t)(qblk >= 8 ? qblk - 8 : 0) * 64 * 256;
        for (int cb = 0; cb < ncb; ++cb) {
            LAS char* buf = lds + (step & 1) * CP_BUFSZ; ++step;
            *(LAS u32x4*)(buf + skey * CP_KP + sch * 16) = rk; *(LAS u32x4*)(buf + CP_V + skey * AW_VP + sch * 16) = rv;
            if (cb + 1 < ncb) { rk = *(const u32x4*)(kc + (size_t)(64 * (cb + 1) + skey) * 64 + sch * 8); rv = *(const u32x4*)(vc + (size_t)(64 * (cb + 1) + skey) * 64 + sch * 8); }
            else { rk = *(const u32x4*)kw0; rv = *(const u32x4*)(kw0 + 128); }
            LDS_BARRIER();
            load_k_lds(kf, buf, lane);
            bf16x8 vf[2][4]; load_vf(vf, buf + CP_V, lane);
            __builtin_amdgcn_sched_barrier(0);
#pragma unroll
            for (int s = 0; s < 2; ++s) {
                qk_scores<16>(sc, kf, qf[s], myq[s] - 31 - 1024 * cb, 0x7fffffffu, tbh, t2h, h, mr2[s], bfar);
                exp4(sc);
                bf16x8 pb[2]; pack_p(pb, sc);
                pv_acc(st[s].o, pb, vf);
                LAS float* ig = (LAS float*)(lds + CP_IMPG) + (8 * w + 4 * s + qq) * CP_IMPN; LAS float* ip = imp + (8 * w + 4 * s + qq) * CP_IMPN;
#pragma unroll
                for (int t = 0; t < 4; ++t) {
                    float gsum = (sc[t][0] + sc[t][1]) + (sc[t][2] + sc[t][3]), p3 = sc[t][3];
                    gsum = quad_sum(gsum); p3 = quad_sum(p3);
                    if (r == 0) { const int jb = 16 * cb + 4 * t + h; ig[jb] = gsum; ip[jb + 1] = p3; }
                }
            }
        }
#pragma unroll
        for (int s = 0; s < 2; ++s)
#pragma unroll
            for (int dt = 0; dt < 4; ++dt) *(f32x4*)(RBASE(s) + 16 * dt) = st[s].o[dt] * GATE(s, 0);
    }
    const bf16_t* kvs0 = KVS + (size_t)b * SEQ * 256 + g * 64;
    int pend = -1;
    LDS_BARRIER();
    if (w < 2 && w <= qblk) { sel_stage(lds + w * SEL_SLOT, kvs0 + (size_t)w * 64 * 256, lane); pend = w; }
    LDS_WAIT();
    for (int q8 = 0; q8 < 8; ++q8) topk_masks<2>((const LAS float*)(lds + CP_IMPG) + (8 * w + q8) * CP_IMPN, imp + (8 * w + q8) * CP_IMPN, qblk, msk + (8 * w + q8) * 2, lane);
    LDS_WAIT();
    unsigned long long un[2][2], mine[2];
#pragma unroll
    for (int s = 0; s < 2; ++s) {
#pragma unroll
        for (int u = 0; u < 2; ++u) { const LAS unsigned long long* mb = msk + (8 * w + 4 * s) * 2 + u; un[s][u] = uniform64(mb[0] | mb[2] | mb[4] | mb[6]); }
        mine[s] = msk[(8 * w + 4 * s + qq) * 2]; }
    {
        soft_init(st[0]); soft_init(st[1]);
        LDS_BARRIER();
        if (pend >= 0) { VM_WAIT(); if (lane == 0) rdy[pend] = 1u; pend = -1; }
        if (w == 2 && 2 <= qblk) { sel_stage(lds + 2 * SEL_SLOT, kvs0 + (size_t)2 * 64 * 256, lane); pend = 2; }
        int sj = 0, sjj = 3;
        for (int jb = 0; jb <= qblk; ++jb) {
            if (pend >= 0) { VM_WAIT(); if (lane == 0) rdy[pend] = 1u; pend = -1; }
            { const int jj = jb + 3;
              if (jj <= qblk && (jj & 7) == w) {
                  if (jj >= SEL_NS) lds_spin_ge(dn + (jj - SEL_NS), 8u);
                  sel_stage(lds + sjj * SEL_SLOT, kvs0 + (size_t)jj * 64 * 256, lane); pend = jj; } }
            if (jb == 64) { mine[0] = msk[(8 * w + qq) * 2 + 1]; mine[1] = msk[(8 * w + 4 + qq) * 2 + 1]; }
            const int u = jb >> 6, bit = jb & 63;
            const bool need0 = (un[0][u] >> bit) & 1ull, need1 = (un[1][u] >> bit) & 1ull;
            if (need0 || need1) {
                lds_spin_ge(rdy + jb, 1u);
                const LAS char* slot = lds + sj * SEL_SLOT;
                load_k_sw(kf, slot, lane);
                bf16x8 vf[2][4]; load_vf_sw(vf, slot + 8192, lane);
                LDS_WAIT();
                if (lane == 0) __hip_atomic_fetch_add(dn + jb, 1u, __ATOMIC_RELAXED, __HIP_MEMORY_SCOPE_WORKGROUP);
                __builtin_amdgcn_sched_barrier(0);
#pragma unroll
                for (int s = 0; s < 2; ++s) if (s == 0 ? need0 : need1) {
                    const int D0 = ((mine[s] >> bit) & 1ull) ? (myq[s] - 64 * jb) : -1;
                    qk_scores<1>(sc, kf, qf[s], D0, 0x7fffffffu, tbh, t2h, h, mref_of(st[s].m), bfar);
                    online_step(sc, st[s], vf);
                }
            } else if (lane == 0) __hip_atomic_fetch_add(dn + jb, 1u, __ATOMIC_RELAXED, __HIP_MEMORY_SCOPE_WORKGROUP);
            sj = (sj + 1 == SEL_NS) ? 0 : sj + 1; sjj = (sjj + 1 == SEL_NS) ? 0 : sjj + 1;
        }
        VM_WAIT();
        LDS_BARRIER();
#pragma unroll
        for (int s = 0; s < 2; ++s) { const float l = st[s].l[0]; const float f = GATE(s, 1) * (l > 0.f ? 1.f / l : 0.f);
#pragma unroll
            for (int dt = 0; dt < 4; ++dt) *(f32x4*)(RBASE(s) + 16 * dt) = *(const f32x4*)(RBASE(s) + 16 * dt) + st[s].o[dt] * f; }
    }
    {
        soft_init(st[0]); soft_init(st[1]);
        const int kb_lo = qblk >= 8 ? qblk - 8 : 0;
        const bf16_t* kb0 = KVW + ((size_t)b * SEQ + skey) * 256 + g * 64 + sch * 8;
        for (int kb = kb_lo; kb <= qblk; ++kb) {
            LAS char* buf = lds + (step & 1) * CP_BUFSZ; ++step;
            *(LAS u32x4*)(buf + skey * CP_KP + sch * 16) = rk; *(LAS u32x4*)(buf + CP_V + skey * AW_VP + sch * 16) = rv;
            if (kb < qblk) { const bf16_t* p = kb0 + (size_t)(kb + 1) * 64 * 256; rk = *(const u32x4*)p; rv = *(const u32x4*)(p + 128); }
            LDS_BARRIER();
            load_k_lds(kf, buf, lane);
            bf16x8 vf[2][4]; load_vf(vf, buf + CP_V, lane);
            __builtin_amdgcn_sched_barrier(0);
#pragma unroll
            for (int s = 0; s < 2; ++s) {
                qk_scores<1>(sc, kf, qf[s], myq[s] - 64 * kb, 512u, tbh, t2h, h, mref_of(st[s].m), bfar);
                online_step(sc, st[s], vf);
            }
        }
#pragma unroll
        for (int s = 0; s < 2; ++s) { const float l = st[s].l[0]; const float f = GATE(s, 2) * (l > 0.f ? 1.f / l : 0.f);
#pragma unroll
            for (int dt = 0; dt < 4; ++dt) {
                const f32x4 rv4 = *(const f32x4*)(RBASE(s) + 16 * dt) + st[s].o[dt] * f;
#ifdef ATTN_CHECK
                *(f32x4*)(RBASE(s) + 16 * dt) = rv4;
#endif
                const size_t mo = MYROW(s) * 1024 + 512 + head * 64 + 16 * dt + 4 * h;
                const u32x2 z = *(const u32x2*)(MIX + mo);
                u32x2 wv; wv.x = pk2(rv4[0] * bflo(z.x), rv4[1] * bfhi(z.x)); wv.y = pk2(rv4[2] * bflo(z.y), rv4[3] * bfhi(z.y));
                *(u32x2*)(MIXO + mo) = wv;
            } }
    }
#undef MYROW
#undef RBASE
#undef GATE
}

__device__ __forceinline__ void coop_sample_task(Frame& F, int b, int g, const LAS float* tb) {
    int tid_ = threadIdx.x; asm volatile("" : "+v"(tid_));
    const int lane = tid_ & 63, w = F.wave, h = lane >> 4, j = lane & 15, qq = j >> 2, r = j & 3;
    const int st = w & 1, wi = w >> 1;
    const int head = g * 4 + r, t0 = 4 * st, qpos0 = PAST + t0, myq = qpos0 + qq;
    const size_t myrow = (size_t)MP + b * 8 + t0 + qq;
    const LAS float* tbh = tb + head;
    const float bfar = tbh[128 * 8];
    LAS char* lds = (LAS char*)F.lds;
    const LAS f32x4* t2h = (const LAS f32x4*)(lds + LDS_T2) + head * T2N + 1;
    LAS char* vs = lds + w * AW_BYTES + AW_V;
    LAS float* imp = (LAS float*)(lds + st * AW_BYTES + AW_IMP);
    LAS float* impp = (LAS float*)(lds + (st + 2) * AW_BYTES + AW_IMP);
    LAS unsigned long long* msk = (LAS unsigned long long*)(lds + st * AW_BYTES + AW_MSK);
    LAS float* xch = (LAS float*)(lds + LDS_XCH);
    bf16x8 qf[2];
#pragma unroll
    for (int ks = 0; ks < 2; ++ks) qf[ks] = *(const bf16x8*)(Q + myrow * 512 + head * 64 + 32 * ks + 8 * h);
    const float* gp = GATES + myrow * 24 + head * 3;
    const float g_c = gp[0], g_s = gp[1], g_w = gp[2];
    __syncthreads();
    bf16x8 kf[4][2]; Sc4 sc;
    f32x4 res[4];
    const bf16_t* kc = KCS + ((size_t)(b * 2 + g) * NCS) * 64; const bf16_t* vc = kc + (size_t)DB * 2 * NCS * 64;
    const int Dc = myq - 31;
    SoftSt sc1; soft_init(sc1);
    for (int cb = wi; cb < 16; cb += 4) {
        SrcBf16 src{kc + (size_t)cb * 64 * 64, vc + (size_t)cb * 64 * 64, 64};
        load_k(kf, src, lane);
        qk_scores<16>(sc, kf, qf, Dc - 1024 * cb, 0x7fffffffu, tbh, t2h, h, mref_of(sc1.m), bfar);
        stats_step(sc, sc1);
    }
    if (h == 0) { xch[(w * 3 + 0) * 32 + j] = sc1.m; xch[(w * 3 + 0) * 32 + 16 + j] = sc1.l[0]; }
    __syncthreads();
    {
        float M = -INFINITY, L = 0.f;
#pragma unroll
        for (int k = 0; k < 4; ++k) M = fmaxf(M, xch[((st + 2 * k) * 3 + 0) * 32 + j]);
        const float Mu = (M == -INFINITY) ? 0.f : M;
#pragma unroll
        for (int k = 0; k < 4; ++k) L += xch[((st + 2 * k) * 3 + 0) * 32 + 16 + j] * __builtin_amdgcn_exp2f(xch[((st + 2 * k) * 3 + 0) * 32 + j] - Mu);
        const float mr2 = (L > 0.f) ? Mu + __builtin_amdgcn_logf(L) : 0.f;
        f32x4 o[4];
#pragma unroll
        for (int dt = 0; dt < 4; ++dt) o[dt] = (f32x4){0.f, 0.f, 0.f, 0.f};
        for (int cb = wi; cb < 16; cb += 4) {
            SrcBf16 src{kc + (size_t)cb * 64 * 64, vc + (size_t)cb * 64 * 64, 64};
            load_k(kf, src, lane); stage_v(vs, src, lane);
            qk_scores<16>(sc, kf, qf, Dc - 1024 * cb, 0x7fffffffu, tbh, t2h, h, mr2, bfar);
            exp4(sc);
            bf16x8 vf[2][4]; load_vf(vf, vs, lane);
            bf16x8 pb[2]; pack_p(pb, sc);
            pv_acc(o, pb, vf);
#pragma unroll
            for (int t = 0; t < 4; ++t) {
                float gsum = (sc[t][0] + sc[t][1]) + (sc[t][2] + sc[t][3]), p3 = sc[t][3];
                gsum = quad_sum(gsum); p3 = quad_sum(p3);
                if (r == 0) { const int jb = 16 * cb + 4 * t + h; imp[qq * AW_IMPN + jb] = gsum; impp[qq * AW_IMPN + jb + 1] = p3; }
            }
        }
#pragma unroll
        for (int dt = 0; dt < 4; ++dt) res[dt] = o[dt] * g_c;
    }
    __syncthreads();
    topk_masks<5>(imp + wi * AW_IMPN, impp + wi * AW_IMPN, 256, msk + wi * 8, lane);
    __syncthreads();
    SoftSt ss; soft_init(ss);
    {
        int cnt = 0;
#pragma unroll 1
        for (int u = 0; u < 5; ++u) {
            const unsigned long long mine = msk[qq * 8 + u];
            unsigned long long un = uniform64(msk[u] | msk[8 + u] | msk[16 + u] | msk[24 + u]);
            while (un) {
                const int bit = __builtin_ctzll(un); un &= un - 1; const int jb = 64 * u + bit;
                if (((cnt++) & 3) != wi) continue;
                const int D0 = ((mine >> bit) & 1ull) ? (myq - 64 * jb) : -1;
                SrcF32 src;
                if (jb < 256) { const int phys = page_table[b * NPAGES + (jb >> 1)]; src.k = cache_sel + ((size_t)phys * PAGE + (jb & 1) * 64) * 256 + g * 64; src.kmax = 63; }
                else { src.k = F.out + O_SS + (size_t)b * 8 * 256 + g * 64; src.kmax = 7; }
                src.v = src.k + 128;
                load_k(kf, src, lane); stage_v(vs, src, lane);
                bf16x8 vf[2][4]; load_vf(vf, vs, lane);
                qk_scores<1>(sc, kf, qf, D0, 0x7fffffffu, tbh, t2h, h, mref_of(ss.m), bfar);
                online_step(sc, ss, vf);
            }
        }
    }
    SoftSt sw; soft_init(sw);
    {
        const int tq = myq - PAST;
        for (int kb = wi; kb < 9; kb += 4) {
            SrcF32 src;
            if (kb < 8) { src.k = state_win + ((size_t)b * 512 + 64 * kb) * 256 + g * 64; src.kmax = 63; }
            else { src.k = F.out + O_WS + ((size_t)b * 512 + 504) * 256 + g * 64; src.kmax = 7; }
            src.v = src.k + 128;
            load_k(kf, src, lane); stage_v(vs, src, lane);
            bf16x8 vf[2][4]; load_vf(vf, vs, lane);
            qk_scores<1>(sc, kf, qf, 512 + tq - 64 * kb, 512u, tbh, t2h, h, mref_of(sw.m), bfar);
            online_step(sc, sw, vf);
        }
    }
    if (h == 0) { xch[(w * 3 + 1) * 32 + j] = ss.m; xch[(w * 3 + 1) * 32 + 16 + j] = ss.l[0]; xch[(w * 3 + 2) * 32 + j] = sw.m; xch[(w * 3 + 2) * 32 + 16 + j] = sw.l[0]; }
    __syncthreads();
#pragma unroll
    for (int br = 1; br < 3; ++br) {
        float M = -INFINITY, L = 0.f;
#pragma unroll
        for (int k = 0; k < 4; ++k) M = fmaxf(M, xch[((st + 2 * k) * 3 + br) * 32 + j]);
        const float Mu = (M == -INFINITY) ? 0.f : M;
#pragma unroll
        for (int k = 0; k < 4; ++k) L += xch[((st + 2 * k) * 3 + br) * 32 + 16 + j] * __builtin_amdgcn_exp2f(xch[((st + 2 * k) * 3 + br) * 32 + j] - Mu);
        const float f = (br == 1 ? g_s : g_w) * (L > 0.f ? 1.f / L : 0.f) * __builtin_amdgcn_exp2f((br == 1 ? ss.m : sw.m) - Mu);
#pragma unroll
        for (int dt = 0; dt < 4; ++dt) res[dt] = res[dt] + (br == 1 ? ss.o[dt] : sw.o[dt]) * f;
    }
#pragma unroll
    for (int dt = 0; dt < 4; ++dt) *(LAS f32x4*)(vs + (dt * 64 + lane) * 16) = res[dt];
    __syncthreads();
    if (wi == 0) {
#pragma unroll
        for (int dt = 0; dt < 4; ++dt) {
            f32x4 a = *(const LAS f32x4*)(lds + (st + 0) * AW_BYTES + AW_V + (dt * 64 + lane) * 16);
#pragma unroll
            for (int k = 1; k < 4; ++k) a = a + *(const LAS f32x4*)(lds + (st + 2 * k) * AW_BYTES + AW_V + (dt * 64 + lane) * 16);
#ifdef ATTN_CHECK
            *(f32x4*)(WSP(float, WS_DBG) + myrow * 512 + head * 64 + 16 * dt + 4 * h) = a;
#endif
            const size_t mo = myrow * 1024 + 512 + head * 64 + 16 * dt + 4 * h;
            const u32x2 z = *(const u32x2*)(MIX + mo);
            u32x2 wv; wv.x = pk2(a[0] * bflo(z.x), a[1] * bfhi(z.x)); wv.y = pk2(a[2] * bflo(z.y), a[3] * bfhi(z.y));
            *(u32x2*)(MIXO + mo) = wv;
        }
    }
}
constexpr int CW_QHEAD = 8192, CW_QSAMP = 8192 + 64 * 8;
__device__ __forceinline__ void attn_phase(Frame& F, gu32* ctl, const int var) {
    LAS float* tb = (LAS float*)(F.lds + LDS_TB);
    attn_bias_table(F, tb);
    volatile LAS int* tsk = (volatile LAS int*)(F.lds + CP_TASK);
    const unsigned x = xb_xcc_id() & 7u;
    for (;;) {
        __syncthreads();
        if (F.tid == 0) { int idx = -1;
            if (__hip_atomic_load(ctl + CW_QSAMP, RLX_AGENT) < 64u) { const unsigned i = __hip_atomic_fetch_add(ctl + CW_QSAMP, 1u, RLX_AGENT); if (i < 64u) idx = (int)i; }
            tsk[0] = idx; }
        __syncthreads();
        const int idx = tsk[0];
        if (idx < 0) break;
        coop_sample_task(F, idx >> 1, idx & 1, tb);
    }
    for (;;) {
        __syncthreads();
        if (F.tid == 0) { int q = -1, idx = 0;
            for (unsigned tr = 0; tr < 8; ++tr) { const unsigned qq = (x + tr) & 7u;
                if (__hip_atomic_load(ctl + CW_QHEAD + 64 * qq, RLX_AGENT) >= 128u) continue;
                const unsigned i = __hip_atomic_fetch_add(ctl + CW_QHEAD + 64 * qq, 1u, RLX_AGENT);
                if (i < 128u) { q = (int)qq; idx = (int)i; break; } }
            tsk[0] = q; tsk[1] = idx; }
        __syncthreads();
        const int q = tsk[0], idx = tsk[1];
        if (q < 0) break;
        coop_prompt_task(F, q >> 1, q & 1, 127 - idx, tb, var);
    }
}

#ifdef ATTN_CHECK
__device__ __forceinline__ int chk_bucket(int dist) { const int n = dist < 0 ? 0 : dist; if (n < 16) return n; const int large = 16 + (int)(logf((float)n / 16.f) / logf(8.f) * 16.f); return large < 31 ? large : 31; }
__device__ __forceinline__ float wave_max(float v) {
#pragma unroll
    for (int o = 1; o < 64; o <<= 1) v = fmaxf(v, __shfl_xor(v, o));
    return v;
}
__device__ const int CHK_SPECIAL[32] = {0, 1, 2, 3, 4, 15, 16, 29, 30, 31, 32, 33, 46, 47, 48, 62, 63, 64, 65, 100, 127, 128, 511, 512, 513, 700, 1023, 1024, 1025, 4095, 4096, 8191};
struct ChkCtx { bool sample; int b, g, qpos; };
__device__ __forceinline__ float chk_cmp_kv(Frame& F, const ChkCtx& c, int kv, int i, int d) {
    const bf16_t* base = c.sample ? KCS + (size_t)kv * DB * 2 * NCS * 64 + ((size_t)(c.b * 2 + c.g) * NCS + i) * 64 : KC + (size_t)kv * NB * 2 * 512 * 64 + ((size_t)(c.b * 2 + c.g) * 512 + i) * 64;
    return bf2f(base[d]);
}
__device__ __forceinline__ float chk_sel_kv(Frame& F, const ChkCtx& c, int kv, int pos, int d) {
    if (!c.sample) return bf2f(KVS[((size_t)c.b * SEQ + pos) * 256 + kv * 128 + c.g * 64 + d]);
    if (pos < PAST) { const int phys = page_table[c.b * NPAGES + (pos >> 7)]; return bf2f((bf16_t)f2bf(cache_sel[((size_t)phys * PAGE + (pos & 127)) * 256 + kv * 128 + c.g * 64 + d])); }
    const int t = pos - PAST; if (t >= DS) return 0.f;
    return bf2f((bf16_t)f2bf(F.out[O_SS + ((size_t)c.b * DS + t) * 256 + kv * 128 + c.g * 64 + d]));
}
__device__ __forceinline__ float chk_win_kv(Frame& F, const ChkCtx& c, int kv, int pos, int d) {
    if (!c.sample) return bf2f(KVW[((size_t)c.b * SEQ + pos) * 256 + kv * 128 + c.g * 64 + d]);
    const int k = pos - (PAST - 512);
    if (k < 512) return bf2f((bf16_t)f2bf(state_win[((size_t)c.b * 512 + k) * 256 + kv * 128 + c.g * 64 + d]));
    return bf2f((bf16_t)f2bf(F.out[O_WS + ((size_t)c.b * 512 + 504 + (k - 512)) * 256 + kv * 128 + c.g * 64 + d]));
}
__device__ __forceinline__ void check_item(Frame& F, int row, int g, LAS float* wl, gu32* ctl) {
    const int lane = F.lane;
    ChkCtx c; c.sample = row >= MP; c.g = g;
    if (c.sample) { const int rs = row - MP; c.b = rs >> 3; c.qpos = PAST + (rs & 7); } else { c.b = row >> 13; c.qpos = row & (SEQ - 1); }
    const int nc = c.sample ? 1023 : 511, ns = c.sample ? 257 : 128, cur = c.qpos >> 6;
    LAS float* sc = wl;
    LAS float* ps = wl + 1024;
    LAS float* iv = wl + 2048;
    LAS float* qv = wl + 2048 + 264;
    LAS int* sl = (LAS int*)(wl + 2048 + 264 + 256);
    for (int i = lane; i < 256; i += 64) qv[i] = bf2f(Q[(size_t)row * 512 + (g * 4 + (i >> 6)) * 64 + (i & 63)]) * (1.f / LOG2E);
    for (int i = lane; i < 1024; i += 64) ps[i] = 0.f;
    float oc[4], os[4], ow[4];
#pragma unroll
    for (int r = 0; r < 4; ++r) { const int head = g * 4 + r; float mx = -INFINITY;
        for (int i = lane; i < nc; i += 64) { const int cend = 16 * i + 31; float s = -INFINITY;
            if (cend <= c.qpos) { s = 0.f; for (int d = 0; d < 64; ++d) s += qv[r * 64 + d] * chk_cmp_kv(F, c, 0, i, d); s += rel_table[chk_bucket(c.qpos - cend) * 8 + head]; }
            sc[i] = s; mx = fmaxf(mx, s); }
        mx = wave_max(mx); float l = 0.f;
        for (int i = lane; i < nc; i += 64) { const float p = (sc[i] == -INFINITY) ? 0.f : expf(sc[i] - mx); sc[i] = p; l += p; }
        l = wave_sum(l); const float il = l > 0.f ? 1.f / l : 0.f;
        for (int i = lane; i < nc; i += 64) { sc[i] *= il; ps[i] += sc[i]; }
        float a = 0.f; for (int i = 0; i < nc; ++i) a += sc[i] * chk_cmp_kv(F, c, 1, i, lane);
        oc[r] = a; }
    for (int j = lane; j < ns; j += 64) { float a = 0.f; for (int i = 4 * j - 1; i <= 4 * j + 3; ++i) if (i >= 0 && i < nc) a += ps[i];
        const bool forced = (j == 0 || j == cur || j == cur - 1), valid = (64 * j <= c.qpos);
        iv[j] = valid ? a + (forced ? 1e6f : 0.f) : -1e30f; }
    for (int k = 0; k < 16; ++k) { float bv = -INFINITY; int bi = 1 << 30;
        for (int j = lane; j < ns; j += 64) { const float v = iv[j]; if (v > bv) { bv = v; bi = j; } }
        for (int o = 1; o < 64; o <<= 1) { const float ov = __shfl_xor(bv, o); const int oi = __shfl_xor(bi, o); if (ov > bv || (ov == bv && oi < bi)) { bv = ov; bi = oi; } }
        if (lane == 0) { sl[k] = (k < ns && bv > -5e29f) ? bi : -1; if (bi < ns) iv[bi] = -INFINITY; } }
#pragma unroll
    for (int r = 0; r < 4; ++r) { const int head = g * 4 + r; float mx = -INFINITY;
        for (int e = lane; e < 1024; e += 64) { const int blk = sl[e >> 6]; float s = -INFINITY;
            if (blk >= 0) { const int pos = blk * 64 + (e & 63); if (pos <= c.qpos) { s = 0.f; for (int d = 0; d < 64; ++d) s += qv[r * 64 + d] * chk_sel_kv(F, c, 0, pos, d); s += rel_table[chk_bucket(c.qpos - pos) * 8 + head]; } }
            sc[e] = s; mx = fmaxf(mx, s); }
        mx = wave_max(mx); float l = 0.f;
        for (int e = lane; e < 1024; e += 64) { const float p = (sc[e] == -INFINITY) ? 0.f : expf(sc[e] - mx); sc[e] = p; l += p; }
        l = wave_sum(l); const float il = l > 0.f ? 1.f / l : 0.f;
        float a = 0.f; for (int e = 0; e < 1024; ++e) { const float p = sc[e]; if (p != 0.f) a += p * chk_sel_kv(F, c, 1, sl[e >> 6] * 64 + (e & 63), lane); }
        os[r] = a * il; }
#pragma unroll
    for (int r = 0; r < 4; ++r) { const int head = g * 4 + r; float mx = -INFINITY;
        for (int e = lane; e < 512; e += 64) { const int pos = c.qpos - e; float s = -INFINITY;
            if (pos >= 0) { s = 0.f; for (int d = 0; d < 64; ++d) s += qv[r * 64 + d] * chk_win_kv(F, c, 0, pos, d); s += rel_table[chk_bucket(e) * 8 + head]; }
            sc[e] = s; mx = fmaxf(mx, s); }
        mx = wave_max(mx); float l = 0.f;
        for (int e = lane; e < 512; e += 64) { const float p = (sc[e] == -INFINITY) ? 0.f : expf(sc[e] - mx); sc[e] = p; l += p; }
        l = wave_sum(l); const float il = l > 0.f ? 1.f / l : 0.f;
        float a = 0.f; for (int e = 0; e < 512; ++e) { const float p = sc[e]; if (p != 0.f) a += p * chk_win_kv(F, c, 1, c.qpos - e, lane); }
        ow[r] = a * il; }
    bool bad = false;
#pragma unroll
    for (int r = 0; r < 4; ++r) { const int head = g * 4 + r; const float* gp = GATES + (size_t)row * 24 + head * 3;
        const float ref = gp[0] * oc[r] + gp[1] * os[r] + gp[2] * ow[r];
        const float got = WSP(float, WS_DBG)[(size_t)row * 512 + head * 64 + lane];
        const float e2 = wave_sum((ref - got) * (ref - got)), r2 = wave_sum(ref * ref);
        if (!(e2 <= CHECK_TOL * CHECK_TOL * r2)) bad = true; }
    if (lane == 0) { __hip_atomic_fetch_add(ctl + CW_NITEM, 1u, RLX_AGENT); if (bad) __hip_atomic_fetch_add(ctl + CW_NFAIL, 1u, RLX_AGENT); }
}
__device__ __forceinline__ void check_cmp_item(Frame& F, bool sample, int kv, int b, int g, int i, LAS float* wl, gu32* ctl) {
    const int lane = F.lane;
    LAS float* hv = wl;
    float hacc[4];
#pragma unroll
    for (int u = 0; u < 4; ++u) hacc[u] = cmp_b1[kv * 256 + 64 * u + lane];
    for (int k = 0; k < 2048; ++k) { const int l2 = k >> 6, d = k & 63, t = 16 * i + l2; float x;
        if (sample) { const int phys = page_table[b * NPAGES + (t >> 7)]; x = cache_cmp[((size_t)phys * PAGE + (t & 127)) * 256 + kv * 128 + g * 64 + d]; }
        else x = F.out[O_CP + ((size_t)b * SEQ + t) * 256 + kv * 128 + g * 64 + d];
        x += cmp_pe[kv * 2048 + k];
#pragma unroll
        for (int u = 0; u < 4; ++u) hacc[u] += x * cmp_w1[((size_t)kv * 2048 + k) * 256 + 64 * u + lane]; }
#pragma unroll
    for (int u = 0; u < 4; ++u) { const float x = hacc[u]; hv[64 * u + lane] = 0.5f * x * (1.f + tanhf(0.7978845608028654f * (x + 0.044715f * x * x * x))); }
    float o = cmp_b2[kv * 64 + lane];
    for (int hh = 0; hh < 256; ++hh) o += hv[hh] * cmp_w2[((size_t)kv * 256 + hh) * 64 + lane];
    const bf16_t* got = sample ? KCS + (size_t)kv * DB * 2 * NCS * 64 + ((size_t)(b * 2 + g) * NCS + i) * 64 : KC + (size_t)kv * NB * 2 * 512 * 64 + ((size_t)(b * 2 + g) * 512 + i) * 64;
    const float gv = bf2f(got[lane]);
    const float e2 = wave_sum((o - gv) * (o - gv)), r2 = wave_sum(o * o);
    if (lane == 0) { __hip_atomic_fetch_add(ctl + CW_NITEM, 1u, RLX_AGENT); if (!(e2 <= CHECK_TOL * CHECK_TOL * r2)) __hip_atomic_fetch_add(ctl + CW_NFAILC, 1u, RLX_AGENT); }
}
__device__ __forceinline__ void check_phase(Frame& F, gu32* ctl) {
    LAS float* wl = (LAS float*)(F.lds + F.wave * 16384);
    const int gw = F.gw;
    if (gw < 512 && CHECK_SUBSET != 2) {
        const int idx = gw >> 1, g = gw & 1;
        int pos, b;
        if (idx < 32) { pos = CHK_SPECIAL[idx]; b = idx & 3; } else { pos = (idx * 2654435761u) % SEQ; b = idx & 3; }
        check_item(F, b * SEQ + pos, g, wl, ctl);
    } else if (gw >= 512 && gw < 1024 && CHECK_SUBSET != 1) { const int k = gw - 512; check_item(F, MP + (k >> 1), k & 1, wl, ctl); }
    else if (gw >= 1024 && gw < 1024 + 128) { const int k = gw - 1024; const int i = (k < 8) ? (k < 4 ? k : 507 + (k - 4)) : (int)((k * 2654435761u) % 511u); check_cmp_item(F, false, k & 1, (k >> 1) & 3, (k >> 3) & 1, i, wl, ctl); }
    else if (gw >= 1152 && gw < 1024 + 256) { const int k = gw - 1152; const int i = (k < 8) ? (k < 4 ? k : 1019 + (k - 4)) : (int)((k * 2654435761u) % 1023u); check_cmp_item(F, true, k & 1, (k >> 1) & 31, (k >> 6) & 1, i, wl, ctl); }
}
#endif
__device__ __forceinline__ void attn_bias_table(Frame& F, LAS float* tb) {
    for (int i = F.tid; i < 129 * 8; i += 512) { const int d = i >> 3, hd = i & 7; const int bk = d < 128 ? T5_BUCKET[d] : 31; tb[i] = rel_table[bk * 8 + hd] * LOG2E; }
    __syncthreads();
    LAS f32x4* t2 = (LAS f32x4*)(F.lds + LDS_T2);
    for (int i = F.tid; i < 8 * T2N; i += 512) { const int hd = i / T2N, k = i % T2N, e = k - 1, x = k - 134; f32x4 v;
#pragma unroll
        for (int r = 0; r < 4; ++r) { const int d = e - r; v[r] = (k < 133) ? (d < 0 ? -INFINITY : tb[(d > 128 ? 128 : d) * 8 + hd]) : (x - r < 0 ? tb[128 * 8 + hd] : -INFINITY); }
        t2[i] = v; }
    __syncthreads();
}

constexpr int N_PHASES = 6;
__device__ __forceinline__ void sample_outproj(Frame& F) {
    const int lane = F.lane, w = F.wave, j = lane & 15, h = lane >> 4;
    LAS f32x4* red = (LAS f32x4*)F.lds;
    for (int t = blockIdx.x; t < (MS / 16) * 16; t += F.G) {
        const int r0 = 16 * (t >> 4), n0 = 64 * (t & 15);
        const bf16_t* ap = WoutT + (size_t)(n0 + j) * DM + 128 * w + 8 * h;
        const bf16_t* bp = MIXO + (size_t)(MP + r0 + j) * DM + 128 * w + 8 * h;
        bf16x8 bq[4];
#pragma unroll
        for (int ks = 0; ks < 4; ++ks) bq[ks] = *(const bf16x8*)(bp + 32 * ks);
        f32x4 acc[4];
#pragma unroll
        for (int nt = 0; nt < 4; ++nt) { acc[nt] = (f32x4){0.f, 0.f, 0.f, 0.f};
#pragma unroll
            for (int ks = 0; ks < 4; ++ks) acc[nt] = __builtin_amdgcn_mfma_f32_16x16x32_bf16(*(const bf16x8*)(ap + (size_t)nt * 16 * DM + 32 * ks), bq[ks], acc[nt], 0, 0, 0); }
#pragma unroll
        for (int nt = 0; nt < 4; ++nt) red[(w * 4 + nt) * 64 + lane] = acc[nt];
        __syncthreads();
        if (w < 4) { f32x4 sm = red[w * 64 + lane];
#pragma unroll
            for (int ww = 1; ww < 8; ++ww) sm = sm + red[(ww * 4 + w) * 64 + lane];
            const size_t o = (size_t)(r0 + j) * DM + n0 + 16 * w + 4 * h;
            *(f32x4*)(F.out + O_YS + o) = sm + *(const f32x4*)(x_sample + o); }
        __syncthreads();
    }
}

struct Args { const void* in[19]; float* out; unsigned char* ws; int ph_lo, ph_hi, li, pad; };

__global__ void __launch_bounds__(512, 2) fwd(Args args) {
    extern __shared__ __attribute__((aligned(16))) unsigned char lds[];
    Frame F;
    F.lds = (LAS unsigned char*)lds;
    volatile LAS unsigned* MISC = (volatile LAS unsigned*)(F.lds + LDS_MISC);
    F.tid = threadIdx.x; F.lane = F.tid & 63; F.wave = __builtin_amdgcn_readfirstlane(F.tid >> 6);
    F.G = gridDim.x; { const int bx = blockIdx.x; F.vcu = (F.G % 8 == 0) ? (bx % 8) * (F.G / 8) + bx / 8 : bx; }
    F.gw = F.vcu * 8 + F.wave; F.NGW = F.G * 8;
    F.ws = args.ws; F.out = args.out; F.in = args.in;
    gu32* ctl = (gu32*)(args.ws + WS_CTL);
    if (F.tid < 32) MISC[F.tid] = 0u;
    __syncthreads();
    XcdBarrier bar; bar.bar = (unsigned*)(ctl + CW_BAR) + args.li * XCD_BAR_WORDS; bar.x = 0; bar.st = nullptr;
    if (MK_N_LAUNCHES != N_PHASES) bar = xcd_barrier_post((unsigned*)(ctl + CW_BAR) + args.li * XCD_BAR_WORDS, MISC + 8);
#define GRID_BAR() do { if (MK_N_LAUNCHES != N_PHASES) xcd_barrier(bar); } while (0)
    const int lo = args.ph_lo, hi = args.ph_hi;
#ifndef PH_MASK
#define PH_MASK 0x3f
#endif
#define IN(k) (((PH_MASK >> (k)) & 1) && lo <= (k) && (k) < hi)
#define BOTH(k) (IN(k) && IN((k) + 1))
#define NREP(k) ((k) == REP_PHASE ? 2 : 1)

    if (IN(0)) { for (int rep = 0; rep < NREP(0); ++rep) p0_prologue(F); if (BOTH(0)) GRID_BAR(); }

    if (IN(1)) {
        {
            pg8::Gemm g{H, WinT, DM, DM}; pg8::StaticOrder S0; S0.init(MP, NPAD, F.G, (int)blockIdx.x);
            EpiInProj E{F.ws, F.out};
            const int k = (int)(blockIdx.x >> 3) & 7;
            { pg8::SubOrder<pg8::StaticOrder> S{S0, 0, k}; pg8::gemm_phase<EpiInProj, pg8::SubOrder<pg8::StaticOrder>>(F.lds, g, S, E); }
            convert_rows(F, (F.G - 1 - (int)blockIdx.x) & 255);
            asm volatile("s_waitcnt vmcnt(0)" ::: "memory"); __syncthreads();
            { pg8::SubOrder<pg8::StaticOrder> S{S0, k, 1 << 20}; pg8::gemm_phase<EpiInProj, pg8::SubOrder<pg8::StaticOrder>>(F.lds, g, S, E); }
        }
        for (int rep = 0; rep < NREP(2); ++rep) {
        { pg8::Gemm g{ACS, W1T, 1024, 2048}; pg8::KvOrder S; S.init(DB * 2 * NCS / 256, F.G, F.G - 1 - (int)blockIdx.x);
          EpiCmp<1> E{HCS, 256, HB, 256, 256};
          pg8::gemm_phase<EpiCmp<1>, pg8::KvOrder>(F.lds, g, S, E); }
        { pg8::Gemm g{HCS, W2T, 256, 256}; pg8::KvOrder S; S.init(DB * 2 * NCS / 256, F.G, F.G - 1 - (int)blockIdx.x);
          EpiCmp<0> E{KCS, 64, cmp_b2, 64, 64};
          pg8::gemm_phase<EpiCmp<0>, pg8::KvOrder>(F.lds, g, S, E); }
        }
        if (BOTH(1)) GRID_BAR();
    }

    if (IN(2)) {
        for (int rep = 0; rep < NREP(3); ++rep) {
        { pg8::Gemm g{AC, W1T, 1024, 2048}; pg8::KvOrder S; S.init(NB * 2 * 512 / 256, F.G, (int)blockIdx.x);
          EpiCmp<1> E{HC, 256, HB, 256, 256};
          pg8::gemm_phase<EpiCmp<1>, pg8::KvOrder>(F.lds, g, S, E); }
        { pg8::Gemm g{HC, W2T, 256, 256}; pg8::KvOrder S; S.init(NB * 2 * 512 / 256, F.G, (int)blockIdx.x);
          EpiCmp<0> E{KC, 64, cmp_b2, 64, 64};
          pg8::gemm_phase<EpiCmp<0>, pg8::KvOrder>(F.lds, g, S, E); }
        }
        { const int c = (int)blockIdx.x - 32;
          pg8::Gemm g{H, WinT, DM, DM}; pg8::OneUnit S{MP / 256, c, c >= 0 && c < NPAD / 256};
          EpiInProj E{F.ws, F.out};
          pg8::gemm_phase<EpiInProj, pg8::OneUnit>(F.lds, g, S, E); }
        __syncthreads();
        if (args.pad & 32) {} else
        if (F.G == 256) {
            const int rk = ((int)blockIdx.x - 32) * 8 + F.wave;
            if (rk >= 0) { spatial_task(F, rk >> 3, rk & 7, (LAS char*)(F.lds + F.wave * SP_BYTES));
                if (rk >= 1536) { const int t2 = 1792 + (1791 - rk); spatial_task(F, t2 >> 3, t2 & 7, (LAS char*)(F.lds + F.wave * SP_BYTES)); } }
        } else
        for (int t = F.gw; t < (MP / 128) * 8; t += F.NGW) spatial_task(F, t >> 3, t & 7, (LAS char*)(F.lds + F.wave * SP_BYTES));
        if (BOTH(2)) GRID_BAR();
    }

    if (IN(3)) {
        for (int t = F.gw; t < DB * 8; t += F.NGW) spatial_sample_task(F, t >> 3, t & 7);
        attn_phase(F, ctl, args.pad);
        if (BOTH(3)) GRID_BAR();
    }

#ifdef ATTN_CHECK
    if (IN(4)) { check_phase(F, ctl); __syncthreads(); }
#endif
    const bool fused_norm = (F.G == 256);
    if (IN(4)) {
        pg8::Gemm g{MIXO, WoutT, DM, DM}; pg8::StaticOrder S; S.init(MP, DM, F.G, (int)blockIdx.x);
        if (fused_norm) {
            sample_outproj(F);
            EpiOutNorm E{x_prompt, final_g, F.out, (unsigned*)(F.ws + WS_XS), (unsigned*)(ctl + CW_PANEL), (unsigned*)(ctl + CW_BAR + XB_TMO), F.lds + RING_BYTES};
            pg8::gemm_phase<EpiOutNorm, pg8::StaticOrder>(F.lds, g, S, E);
        } else {
            EpiOut E{x_prompt, x_sample, F.out};
            pg8::gemm_phase<EpiOut, pg8::StaticOrder>(F.lds, g, S, E);
        }
        if (BOTH(4)) GRID_BAR();
    }

    if (IN(5)) {
        const unsigned bad = __hip_atomic_load(ctl + CW_BAR + XB_TMO, RLX_AGENT);
        int m0, mstep, mend;
        if (fused_norm) { m0 = MP + F.gw; mstep = F.NGW; mend = MT; }
        else if (F.vcu < 4) {
            { pg8::Gemm g{MIXO, WoutT, DM, DM}; pg8::OneUnit S{MP / 256, F.vcu, true};
              EpiOut E{x_prompt, x_sample, F.out};
              pg8::gemm_phase<EpiOut, pg8::OneUnit>(F.lds, g, S, E); }
            if (F.tid == 0) {
                __builtin_amdgcn_fence(__ATOMIC_RELEASE, "agent");
                asm volatile("s_waitcnt vmcnt(0)" ::: "memory");
                __hip_atomic_fetch_add(ctl + CW_SOUT, 1u, RLX_AGENT);
                unsigned sp = 0;
                while (__hip_atomic_load(ctl + CW_SOUT, RLX_AGENT) < 4u) { __builtin_amdgcn_s_sleep(2); if (++sp > (1u << 22)) { __hip_atomic_store(ctl + CW_BAR + XB_TMO, 1u, RLX_AGENT); break; } }
                __builtin_amdgcn_fence(__ATOMIC_ACQUIRE, "agent");
                asm volatile("s_waitcnt vmcnt(0)" ::: "memory");
            }
            __syncthreads();
            m0 = MP + 64 * F.vcu + F.wave; mstep = 8; mend = MP + 64 * F.vcu + 64;
        } else { m0 = (F.vcu - 4) * 8 + F.wave; mstep = (F.G - 4) * 8; mend = MP; }
        const unsigned bad2 = bad | __hip_atomic_load(ctl + CW_BAR + XB_TMO, RLX_AGENT);
        for (int m = m0; m < mend; m += mstep) {
            float* yr = F.out + (size_t)m * DM;
            f32x4 v[4]; float s = 0.f;
#pragma unroll
            for (int j = 0; j < 4; ++j) { v[j] = *(const f32x4*)(yr + 256 * j + 4 * F.lane); s += (v[j][0] * v[j][0] + v[j][1] * v[j][1]) + (v[j][2] * v[j][2] + v[j][3] * v[j][3]); }
            float rs = 1.f / sqrtf(wave_sum(s) * (1.f / DM) + 1e-6f);
            if (bad2) rs = __builtin_nanf("");
#pragma unroll
            for (int j = 0; j < 4; ++j) { const f32x4 g = *(const f32x4*)(final_g + 256 * j + 4 * F.lane); *(f32x4*)(yr + 256 * j + 4 * F.lane) = v[j] * rs * g; }
        }
    }
#ifdef ATTN_CHECK
    if (IN(5) && blockIdx.x == 0 && F.tid == 0) {
        VM_WAIT();
        const unsigned nf = __hip_atomic_load(ctl + CW_NFAIL, RLX_AGENT), nfc = __hip_atomic_load(ctl + CW_NFAILC, RLX_AGENT), ni = __hip_atomic_load(ctl + CW_NITEM, RLX_AGENT);
        F.out[O_YS + 0] += 1000.f * (float)nf; F.out[O_YS + 1] += 100000.f * (float)nfc; if (ni != 1280u && CHECK_SUBSET == 0) F.out[O_YS + 2] += 1e7f;
    }
#endif
#undef IN
#undef BOTH
}

extern "C" void kernel_launch(void* const* d_in, const int* in_sizes, int n_in, void* d_out, int out_size, void* d_ws, size_t ws_size, hipStream_t stream) {
    static int grid = 0;
    if (grid == 0) {
        if (n_in != 19 || ws_size < WS_END) { fprintf(stderr, "kernel_launch: unexpected inputs (n_in %d, ws %zu)\n", n_in, ws_size); grid = -1; return; }
        int dev = 0, cus = 0;
        if (hipGetDevice(&dev) != hipSuccess || hipDeviceGetAttribute(&cus, hipDeviceAttributeMultiprocessorCount, dev) != hipSuccess) { grid = -1; return; }
        if (hipFuncSetAttribute((const void*)fwd, hipFuncAttributeMaxDynamicSharedMemorySize, LDS_BYTES) != hipSuccess) { fprintf(stderr, "kernel_launch: hipFuncSetAttribute failed\n"); grid = -1; return; }
        int per_cu = 0;
        if (hipOccupancyMaxActiveBlocksPerMultiprocessor(&per_cu, (const void*)fwd, 512, LDS_BYTES) != hipSuccess || per_cu < 1) fprintf(stderr, "kernel_launch: occupancy query says %d\n", per_cu);
        (void)hipGetLastError();
        grid = cus;
    }
    if (grid < 0) return;
    (void)hipMemsetAsync((char*)d_ws + WS_CTL, 0, CTL_ZERO_BYTES, stream);
    Args a{};
    for (int i = 0; i < 19; ++i) a.in[i] = d_in[i];
    a.out = (float*)d_out; a.ws = (unsigned char*)d_ws;
    if (MK_N_LAUNCHES == 1) { a.ph_lo = 0; a.ph_hi = N_PHASES; a.li = 0; hipLaunchKernelGGL(fwd, dim3(grid), dim3(512), LDS_BYTES, stream, a);
#if REP_PHASE >= 20 && REP_PHASE <= 24
        for (int rc = 0; rc < REP_COUNT; ++rc) {
        (void)hipMemsetAsync((char*)d_ws + WS_CTL, 0, CTL_ZERO_BYTES, stream);
        a.ph_lo = REP_PHASE - 20; a.ph_hi = (REP_PHASE == 24) ? 6 : REP_PHASE - 19; a.li = 0; a.pad = PROBE_VAR; hipLaunchKernelGGL(fwd, dim3(grid), dim3(512), LDS_BYTES, stream, a); }
#endif
#if REP_PHASE == 5 || REP_PHASE == 8 || REP_PHASE == 9
        if (REP_PHASE != 9) (void)hipMemsetAsync((char*)d_ws + WS_CTL + (size_t)CW_QHEAD * 4, 0, 8 * 256, stream);
        if (REP_PHASE != 8) (void)hipMemsetAsync((char*)d_ws + WS_CTL + (size_t)CW_QSAMP * 4, 0, 256, stream);
        a.ph_lo = 3; a.ph_hi = 4; a.li = 1; a.pad = PROBE_VAR; hipLaunchKernelGGL(fwd, dim3(grid), dim3(512), LDS_BYTES, stream, a);
#endif
    }
    else for (int li = 0; li < N_PHASES; ++li) { a.ph_lo = li; a.ph_hi = li + 1; a.li = 0; hipLaunchKernelGGL(fwd, dim3(grid), dim3(512), LDS_BYTES, stream, a); }
}
```

```cpp
#include <hip/hip_runtime.h>
#include <cstdio>
#include <cstdint>

#ifndef CHECK_SUBSET
#define CHECK_SUBSET 0
#endif
#ifndef CHECK_TOL
#define CHECK_TOL 0.03f
#endif
#ifndef REP_PHASE
#define REP_PHASE -1
#endif
#ifndef PROBE_VAR
#define PROBE_VAR 0
#define REP_COUNT 4
#endif
#ifndef MK_N_LAUNCHES
#define MK_N_LAUNCHES 1
#endif

#define LAS __attribute__((address_space(3)))
#define GAS __attribute__((address_space(1)))
typedef unsigned short bf16_t;
typedef short bf16x8 __attribute__((ext_vector_type(8)));
typedef short s16x4 __attribute__((ext_vector_type(4)));
typedef float f32x4 __attribute__((ext_vector_type(4)));
typedef float f32x2 __attribute__((ext_vector_type(2)));
typedef unsigned u32x4 __attribute__((ext_vector_type(4)));
typedef unsigned u32x2 __attribute__((ext_vector_type(2)));
typedef __bf16 bf16x2_t __attribute__((ext_vector_type(2)));
typedef GAS unsigned gu32;

constexpr int DM = 1024, NB = 4, SEQ = 8192, MP = NB * SEQ;
constexpr int DB = 32, DS = 8, MS = DB * DS, MT = MP + MS;
constexpr int PAST = 16384, PAGE = 128, NPAGES = 128;
constexpr int D_IN = 3352, NPAD = 3584;
constexpr int NCS = 1024;
constexpr float LOG2E = 1.4426950408889634f;
constexpr size_t O_YP = 0, O_YS = 33554432, O_CP = 33816576, O_SP = 42205184, O_WP = 50593792, O_CS = 51118080, O_SS = 51183616, O_WS = 51249152, O_CV = 55443456;

constexpr size_t MiB = 1u << 20;
constexpr size_t WS_CTL = 0, CTL_ZERO_BYTES = 64 * 1024;
constexpr size_t WS_WIN = 2 * MiB;
constexpr size_t WS_WOUT = 10 * MiB;
constexpr size_t WS_W1T = 12 * MiB;
constexpr size_t WS_W2T = 14 * MiB;
constexpr size_t WS_SW = 15 * MiB;
constexpr size_t WS_HB = 15 * MiB + 512 * 1024;
constexpr size_t WS_GATES = 16 * MiB;
constexpr size_t WS_H = 20 * MiB;
constexpr size_t WS_UA = 86 * MiB;
constexpr size_t WS_VG = 120 * MiB;
constexpr size_t WS_Q = 154 * MiB;
constexpr size_t WS_MIX = 188 * MiB;
constexpr size_t WS_KVS = 254 * MiB;
constexpr size_t WS_KVW = 272 * MiB;
constexpr size_t WS_AC = 290 * MiB;
constexpr size_t WS_HC = 308 * MiB;
constexpr size_t WS_KC = 313 * MiB;
constexpr size_t WS_KCS = 315 * MiB;
constexpr size_t WS_HCS = 332 * MiB;
constexpr size_t WS_ACS = 400 * MiB;
constexpr size_t WS_MIXO = 660 * MiB;
constexpr size_t WS_DBG = 726 * MiB;
constexpr size_t WS_END = 792 * MiB;

constexpr int CW_TMO = 0;
constexpr int CW_BAR = 4096;
constexpr int CW_NFAIL = 64, CW_NFAILC = 128, CW_NITEM = 192, CW_SOUT = 320;
constexpr int CW_PANEL = 9216;
constexpr size_t WS_XS2 = 1 * MiB + 768 * 1024;
constexpr size_t WS_XS = 1 * MiB;

constexpr int RING_BYTES = 131072;
constexpr int LDS_MISC = 150528;
constexpr int LDS_BYTES = 151552;
constexpr int AW_V = 0, AW_VP = 160, AW_IMP = 10240, AW_IMPN = 272, AW_MSK = 10240 + 4 * 272 * 4, AW_BYTES = 14848;
constexpr int LDS_TB = 8 * AW_BYTES;
constexpr int SP_PITCH = 136, SP_BYTES = 128 * SP_PITCH;

#define RLX_AGENT __ATOMIC_RELAXED, __HIP_MEMORY_SCOPE_AGENT
#define LDS_WAIT() asm volatile("s_waitcnt lgkmcnt(0)" ::: "memory")
#define VM_WAIT() asm volatile("s_waitcnt vmcnt(0)" ::: "memory")
#define LDS_BARRIER() asm volatile("s_waitcnt lgkmcnt(0)\n\ts_barrier" ::: "memory")

__device__ __forceinline__ unsigned f2bf(float f) { unsigned u = __builtin_bit_cast(unsigned, f); return (u + 0x7fffu + ((u >> 16) & 1u)) >> 16; }
__device__ __forceinline__ unsigned pk2(float lo, float hi) { f32x2 v = {lo, hi}; bf16x2_t b = __builtin_convertvector(v, bf16x2_t); return __builtin_bit_cast(unsigned, b); }
__device__ __forceinline__ float bf2f(unsigned short b) { return __builtin_bit_cast(float, (unsigned)b << 16); }
__device__ __forceinline__ float bflo(unsigned w) { return __builtin_bit_cast(float, w << 16); }
__device__ __forceinline__ float bfhi(unsigned w) { return __builtin_bit_cast(float, w & 0xffff0000u); }
__device__ __forceinline__ float fast_sigmoid(float x) { return __builtin_amdgcn_rcpf(1.f + __builtin_amdgcn_exp2f(-x * LOG2E)); }
__device__ __forceinline__ float silu_f(float x) { return x * fast_sigmoid(x); }
__device__ __forceinline__ float gelu_f(float x) { const float u2 = x * (1.5957691216057308f + 0.07135481627466319f * x * x); return x * fast_sigmoid(u2); }
__device__ __forceinline__ float wave_sum(float v) {
    v += __builtin_bit_cast(float, __builtin_amdgcn_update_dpp(0, __builtin_bit_cast(int, v), 0xB1, 0xF, 0xF, true));
    v += __builtin_bit_cast(float, __builtin_amdgcn_update_dpp(0, __builtin_bit_cast(int, v), 0x4E, 0xF, 0xF, true));
    v += __builtin_bit_cast(float, __builtin_amdgcn_update_dpp(0, __builtin_bit_cast(int, v), 0x124, 0xF, 0xF, true));
    v += __builtin_bit_cast(float, __builtin_amdgcn_update_dpp(0, __builtin_bit_cast(int, v), 0x128, 0xF, 0xF, true));
    { auto a = __builtin_amdgcn_permlane16_swap(__float_as_uint(v), __float_as_uint(v), false, false); v = __uint_as_float(a[0]) + __uint_as_float(a[1]); }
    { auto c = __builtin_amdgcn_permlane32_swap(__float_as_uint(v), __float_as_uint(v), false, false); v = __uint_as_float(c[0]) + __uint_as_float(c[1]); }
    return v;
}

namespace pg8 {
constexpr int BM = 256, BK = 64, HALF = 128, HTB = HALF * BK * 2, NXCD = 8, WGM = 8;
__host__ __device__ __forceinline__ int lds_byte(int r, int c) { const int st = (r >> 4) * 2 + (c >> 5), rr = r & 15, cc = c & 31, ob = rr * 64 + cc * 2; return st * 1024 + (ob ^ (((ob >> 9) & 1) << 5)); }
__host__ __device__ __forceinline__ void stage_rc(int b, int& R, int& C) { const int st = b / 1024, sb = b % 1024, swz = sb ^ (((sb >> 9) & 1) << 5); R = (st >> 1) * 16 + swz / 64; C = (st & 1) * 32 + (swz % 64) / 2; }
__host__ __device__ __forceinline__ int perm32(int rho) { const int n = rho >> 4, i = rho & 15; return 8 * (i >> 2) + 4 * n + (i & 3); }

struct Unit { int pm, pn; };
struct Gemm { const bf16_t* A; const bf16_t* Bt; int lda, K; };

struct StaticOrder {
    int nM, nN, nwg, G, c;
    __device__ void init(int M, int N, int G_, int c_) { nM = M / BM; nN = N / BM; nwg = nM * nN; G = G_; c = c_; }
    __device__ bool next(int i, Unit& u) const {
        const long L = (long)i * G + c; if (L >= nwg) return false;
        int wgid = (int)L; { const int q = nwg / NXCD, r = nwg % NXCD, xcd = wgid % NXCD, off = wgid / NXCD; wgid = (xcd < r ? xcd * (q + 1) : r * (q + 1) + (xcd - r) * q) + off; }
        const int nig = WGM * nN, gid = wgid / nig, fm = gid * WGM, gsz = (nM - fm) < WGM ? (nM - fm) : WGM;
        u.pm = fm + ((wgid % nig) % gsz); u.pn = (wgid % nig) / gsz; return true;
    }
};
struct KvOrder {
    int nunits, mt_per_kv, G, c;
    __device__ void init(int mt_per_kv_, int G_, int c_) { mt_per_kv = mt_per_kv_; nunits = 2 * mt_per_kv_; G = G_; c = c_; }
    __device__ bool next(int i, Unit& u) const { const int L = i * G + c; if (L >= nunits) return false; u.pm = L; u.pn = L / mt_per_kv; return true; }
};

template <class S_> struct SubOrder { S_ S; int i0, n; __device__ bool next(int i, Unit& u) const { return i < n && S.next(i0 + i, u); } };
struct OneUnit { int pm, pn; bool on; __device__ bool next(int i, Unit& u) const { if (i != 0 || !on) return false; u.pm = pm; u.pn = pn; return true; } };

template <class Epi, class Sched>
__device__ __forceinline__ void gemm_phase(LAS unsigned char* lds, const Gemm g, const Sched& S, const Epi& E) {
    const int tid = threadIdx.x, wid = __builtin_amdgcn_readfirstlane(tid >> 6), lane = tid & 63, wr = wid >> 2, wc = wid & 3, fr = lane & 15, fq = lane >> 4;
    const int K = g.K, nt = K / BK, lda = g.lda;
    unsigned voffA[2], voffB[2];
#pragma unroll
    for (int i = 0; i < 2; ++i) { int R, C; stage_rc(tid * 16 + i * 8192, R, C); const int Rb = Epi::PERM ? ((R & ~31) + perm32(R & 31)) : R;
        voffA[i] = (unsigned)(R * lda + C) * 2u; voffB[i] = (unsigned)(Rb * K + C) * 2u; }
    const size_t kstep = (size_t)(BK * 2);
    const size_t hstepA = (size_t)HALF * lda * 2, hstepB = (size_t)HALF * K * 2;
    const size_t tstepA = 2 * hstepA, tstepB = 2 * hstepB;
    const unsigned ldsw = (unsigned)wid * 1024u;
    const int aoff = lds_byte(wr * 64 + fr, fq * 8), boff = lds_byte(wc * 32 + fr, fq * 8);
#define PG8_SA(b, h) (((b) * 2 + (h)) * HTB)
#define PG8_SB(b, h) ((4 + (b) * 2 + (h)) * HTB)
#define PG8_STAGE(bufoff, gbase, voff) do { _Pragma("unroll") for (int _i = 0; _i < 2; ++_i) \
        __builtin_amdgcn_global_load_lds((const unsigned*)((const char*)(gbase) + (voff)[_i]), (LAS unsigned*)(lds + (bufoff) + ldsw + _i * 8192), 16, 0, 0); } while (0)
#define PG8_LDA(dst, b, h) do { _Pragma("unroll") for (int m = 0; m < 4; ++m) _Pragma("unroll") for (int k = 0; k < 2; ++k) dst[m][k] = *(const LAS bf16x8*)(lds + PG8_SA(b, h) + aoff + m * 2048 + k * 1024); } while (0)
#define PG8_LDB(dst, b, h) do { _Pragma("unroll") for (int n = 0; n < 2; ++n) _Pragma("unroll") for (int k = 0; k < 2; ++k) dst[n][k] = *(const LAS bf16x8*)(lds + PG8_SB(b, h) + boff + n * 2048 + k * 1024); } while (0)
#define PG8_MMA(ai, bj, At, Bt) do { __builtin_amdgcn_s_setprio(1); _Pragma("unroll") for (int m = 0; m < 4; ++m) _Pragma("unroll") for (int n = 0; n < 2; ++n) _Pragma("unroll") for (int k = 0; k < 2; ++k) \
        acc[ai][bj][m][n] = __builtin_amdgcn_mfma_f32_16x16x32_bf16(Bt[n][k], At[m][k], acc[ai][bj][m][n], 0, 0, 0); __builtin_amdgcn_s_setprio(0); } while (0)
#define PG8_WAIT_V(n) asm volatile("s_waitcnt vmcnt(" #n ")" ::: "memory")
#define PG8_WAIT_L(n) asm volatile("s_waitcnt lgkmcnt(" #n ")" ::: "memory")
#define PG8_BAR __builtin_amdgcn_s_barrier()
#define PG8_SCHED __builtin_amdgcn_sched_barrier(0)
    Unit cur, nxt; int ui = 0;
    if (!S.next(0, cur)) return;
    f32x4 acc[2][2][4][2];
    if constexpr (Epi::INIT) E.init(acc, cur, wr, wc, fr, fq);
    else {
#pragma unroll
    for (int a = 0; a < 2; ++a)
#pragma unroll
        for (int b = 0; b < 2; ++b)
#pragma unroll
            for (int m = 0; m < 4; ++m)
#pragma unroll
                for (int n = 0; n < 2; ++n) acc[a][b][m][n] = (f32x4){0.f, 0.f, 0.f, 0.f};
    }
    bf16x8 At[4][2], B0[2][2], B1[2][2];
    const char* cA = (const char*)g.A + (size_t)cur.pm * tstepA; const char* cB = (const char*)g.Bt + (size_t)cur.pn * tstepB;
    PG8_STAGE(PG8_SB(0, 0), cB, voffB); PG8_STAGE(PG8_SB(0, 1), cB + hstepB, voffB); PG8_STAGE(PG8_SA(0, 0), cA, voffA); PG8_STAGE(PG8_SA(0, 1), cA + hstepA, voffA);
    if (wr == 1) PG8_BAR;
    PG8_WAIT_V(2); PG8_BAR;
    PG8_STAGE(PG8_SB(1, 0), cB + kstep, voffB); PG8_STAGE(PG8_SA(1, 0), cA + kstep, voffA); PG8_STAGE(PG8_SB(1, 1), cB + hstepB + kstep, voffB);
    PG8_WAIT_V(6); PG8_BAR;
    for (;;) {
        const bool has_next = S.next(ui + 1, nxt);
        const char* nA = has_next ? (const char*)g.A + (size_t)nxt.pm * tstepA : cA; const char* nB = has_next ? (const char*)g.Bt + (size_t)nxt.pn * tstepB : cB;
        for (int t = 0; t < nt; t += 2) {
            const bool last = (t == nt - 2);
            const char* a1 = cA + (size_t)(t + 1) * kstep;
            const char* a2 = last ? nA : cA + (size_t)(t + 2) * kstep; const char* b2 = last ? nB : cB + (size_t)(t + 2) * kstep;
            const char* a3 = a2 + kstep; const char* b3 = b2 + kstep;
            PG8_LDB(B0, 0, 0); PG8_LDB(B1, 0, 1); PG8_SCHED; PG8_LDA(At, 0, 0); PG8_STAGE(PG8_SA(1, 1), a1 + hstepA, voffA);
            PG8_WAIT_V(8); PG8_WAIT_L(0); PG8_BAR; PG8_MMA(0, 0, At, B0); PG8_MMA(0, 1, At, B1); PG8_BAR; PG8_SCHED;
            PG8_LDA(At, 0, 1); PG8_STAGE(PG8_SB(0, 0), b2, voffB); PG8_STAGE(PG8_SB(0, 1), b2 + hstepB, voffB); PG8_STAGE(PG8_SA(0, 0), a2, voffA);
            PG8_WAIT_V(8); PG8_WAIT_L(0); PG8_BAR; PG8_MMA(1, 0, At, B0); PG8_MMA(1, 1, At, B1); PG8_BAR; PG8_SCHED;
            PG8_LDB(B0, 1, 0); PG8_LDB(B1, 1, 1); PG8_SCHED; PG8_LDA(At, 1, 0); PG8_STAGE(PG8_SA(0, 1), a2 + hstepA, voffA);
            PG8_WAIT_V(8); PG8_WAIT_L(0); PG8_BAR; PG8_MMA(0, 0, At, B0); PG8_MMA(0, 1, At, B1); PG8_BAR; PG8_SCHED;
            PG8_LDA(At, 1, 1); PG8_STAGE(PG8_SB(1, 0), b3, voffB); PG8_STAGE(PG8_SB(1, 1), b3 + hstepB, voffB); PG8_STAGE(PG8_SA(1, 0), a3, voffA);
            PG8_WAIT_V(8); PG8_WAIT_L(0); PG8_BAR; PG8_MMA(1, 0, At, B0); PG8_MMA(1, 1, At, B1); PG8_BAR; PG8_SCHED;
        }
        if (wr == 0) PG8_BAR;
        E(acc, cur, wr, wc, fr, fq);
        if (!has_next) break;
        if constexpr (Epi::INIT) E.init(acc, nxt, wr, wc, fr, fq);
        else {
#pragma unroll
        for (int a = 0; a < 2; ++a)
#pragma unroll
            for (int b = 0; b < 2; ++b)
#pragma unroll
                for (int m = 0; m < 4; ++m)
#pragma unroll
                    for (int n = 0; n < 2; ++n) acc[a][b][m][n] = (f32x4){0.f, 0.f, 0.f, 0.f};
        }
        cur = nxt; cA = nA; cB = nB; ++ui;
        if (wr == 1) PG8_BAR;
    }
    PG8_WAIT_V(0);
    PG8_BAR;
#undef PG8_SA
#undef PG8_SB
#undef PG8_STAGE
#undef PG8_LDA
#undef PG8_LDB
#undef PG8_MMA
#undef PG8_WAIT_V
#undef PG8_WAIT_L
#undef PG8_BAR
#undef PG8_SCHED
}
}

__device__ __forceinline__ void st_bf16x8(bf16_t* p, const f32x4& v0, const f32x4& v1) {
    u32x4 w; w.x = pk2(v0[0], v0[1]); w.y = pk2(v0[2], v0[3]); w.z = pk2(v1[0], v1[1]); w.w = pk2(v1[2], v1[3]); *(u32x4*)p = w;
}
template <int ACT>
__device__ __forceinline__ void epi_store_act(const f32x4 (&acc)[2][2][4][2], bf16_t* dst0, int ld, int rowbase, int colbase) {
#pragma unroll
    for (int ai = 0; ai < 2; ++ai)
#pragma unroll
        for (int m = 0; m < 4; ++m) {
            bf16_t* rp = dst0 + (size_t)(rowbase + ai * 128 + m * 16) * ld + colbase;
#pragma unroll
            for (int bj = 0; bj < 2; ++bj) {
                f32x4 v0 = acc[ai][bj][m][0], v1 = acc[ai][bj][m][1];
                if (ACT == 0) {
#pragma unroll
                    for (int e = 0; e < 4; ++e) { v0[e] = gelu_f(v0[e]); v1[e] = gelu_f(v1[e]); }
                } else if (ACT == 1) {
#pragma unroll
                    for (int e = 0; e < 4; ++e) { v0[e] = silu_f(v0[e]); v1[e] = silu_f(v1[e]); }
                } else { v0 = v0 * (0.125f * LOG2E); v1 = v1 * (0.125f * LOG2E); }
                st_bf16x8(rp + bj * 128, v0, v1);
            }
            asm volatile("" ::: "memory");
        }
}
struct EpiInProj {
    static constexpr bool PERM = true, INIT = false;
    unsigned char* ws; float* out;
    __device__ __forceinline__ void operator()(const f32x4 (&acc)[2][2][4][2], const pg8::Unit& u, int wr, int wc, int fr, int fq) const {
        const int pn = u.pn;
        const bool sample = (u.pm == MP / 256);
        const int rowbase = u.pm * 256 + wr * 64 + fr, cb = wc * 32 + 8 * fq;
        if (pn < 2) epi_store_act<0>(acc, (bf16_t*)(ws + WS_UA), 512, rowbase, pn * 256 + cb);
        else if (pn < 4) epi_store_act<0>(acc, (bf16_t*)(ws + WS_VG), 512, rowbase, (pn - 2) * 256 + cb);
        else if (pn < 6) epi_store_act<1>(acc, (bf16_t*)(ws + WS_MIX), 1024, rowbase, (pn - 4) * 256 + cb);
        else if (pn < 8) epi_store_act<2>(acc, (bf16_t*)(ws + WS_Q), 512, rowbase, (pn - 6) * 256 + cb);
        else if (pn == 11 || pn == 12) epi_store_act<1>(acc, (bf16_t*)(ws + WS_MIX), 1024, rowbase, 512 + (pn - 11) * 256 + cb);
        else if (pn == 13) {
            if (cb < 24) {
                float* gbase = (float*)(ws + WS_GATES);
#pragma unroll
                for (int ai = 0; ai < 2; ++ai)
#pragma unroll
                    for (int m = 0; m < 4; ++m) {
                        f32x4 v0 = acc[ai][0][m][0], v1 = acc[ai][0][m][1];
#pragma unroll
                        for (int e = 0; e < 4; ++e) { v0[e] = fast_sigmoid(v0[e]); v1[e] = fast_sigmoid(v1[e]); }
                        float* gp = gbase + (size_t)(rowbase + ai * 128 + m * 16) * 24 + cb; *(f32x4*)gp = v0; *(f32x4*)(gp + 4) = v1;
                    }
            }
        } else {
            const size_t fbase = sample ? (pn == 8 ? O_CS : O_SS) : (pn == 8 ? O_CP : O_SP);
            bf16_t* bb = (bf16_t*)(ws + (pn == 9 ? WS_KVS : WS_KVW));
#pragma unroll
            for (int ai = 0; ai < 2; ++ai)
#pragma unroll
                for (int m = 0; m < 4; ++m) {
                    const int row = rowbase + ai * 128 + m * 16;
#pragma unroll
                    for (int bj = 0; bj < 2; ++bj) {
                        const int c = bj * 128 + cb;
                        const f32x4 v0 = acc[ai][bj][m][0], v1 = acc[ai][bj][m][1];
                        float* fo = nullptr;
                        if (pn != 10) fo = out + fbase + (size_t)(sample ? row - MP : row) * 256 + c;
                        else if (sample) { const int rs = row - MP; fo = out + O_WS + ((size_t)(rs >> 3) * 512 + 504 + (rs & 7)) * 256 + c; }
                        else { const int t = row & (SEQ - 1); if (t >= SEQ - 512) fo = out + O_WP + ((size_t)(row >> 13) * 512 + (t - (SEQ - 512))) * 256 + c; }
                        if (fo) { *(f32x4*)fo = v0; *(f32x4*)(fo + 4) = v1; }
                        if (!sample) {
                            if (pn == 8) { const int kv = c >> 7, g = (c >> 6) & 1, d = c & 63, b = row >> 13, t = row & (SEQ - 1);
                                st_bf16x8((bf16_t*)(ws + WS_AC) + ((size_t)(((kv * NB + b) * 2 + g) * 512 + (t >> 4))) * 1024 + (t & 15) * 64 + d, v0, v1); }
                            else st_bf16x8(bb + (size_t)row * 256 + c, v0, v1);
                        }
                    }
                    asm volatile("" ::: "memory");
                }
        }
    }
};
struct EpiOut {
    static constexpr bool PERM = true, INIT = false;
    const float* xp; const float* xs; float* out;
    __device__ __forceinline__ void operator()(const f32x4 (&acc)[2][2][4][2], const pg8::Unit& u, int wr, int wc, int fr, int fq) const {
        const int row0 = u.pm * 256 + wr * 64 + fr, c0 = u.pn * 256 + wc * 32 + 8 * fq;
        const float* xb = (row0 < MP) ? xp + (size_t)row0 * DM + c0 : xs + (size_t)(row0 - MP) * DM + c0;
        float* ob = out + (size_t)row0 * DM + c0;
#pragma unroll
        for (int ai = 0; ai < 2; ++ai) {
            f32x4 x[4][2][2];
#pragma unroll
            for (int m = 0; m < 4; ++m)
#pragma unroll
                for (int bj = 0; bj < 2; ++bj) { const float* p = xb + (size_t)(ai * 128 + m * 16) * DM + bj * 128; x[m][bj][0] = *(const f32x4*)p; x[m][bj][1] = *(const f32x4*)(p + 4); }
#pragma unroll
            for (int m = 0; m < 4; ++m)
#pragma unroll
                for (int bj = 0; bj < 2; ++bj) { float* o = ob + (size_t)(ai * 128 + m * 16) * DM + bj * 128;
                    *(f32x4*)o = acc[ai][bj][m][0] + x[m][bj][0]; *(f32x4*)(o + 4) = acc[ai][bj][m][1] + x[m][bj][1]; }
            asm volatile("" ::: "memory");
        }
    }
};
__device__ __forceinline__ float xrow_sum(float m);
struct EpiOutNorm {
    static constexpr bool PERM = true, INIT = true;
    const float* xp; const float* gw; float* out; unsigned* xbuf; unsigned* cnt; unsigned* tmo; LAS unsigned char* tb;
    __device__ __forceinline__ void init(f32x4 (&acc)[2][2][4][2], const pg8::Unit& u, int wr, int wc, int fr, int fq) const {
        const float* xb = xp + (size_t)(u.pm * 256 + wr * 64 + fr) * DM + u.pn * 256 + wc * 32 + 8 * fq;
#pragma unroll
        for (int ai = 0; ai < 2; ++ai)
#pragma unroll
            for (int m = 0; m < 4; ++m)
#pragma unroll
                for (int bj = 0; bj < 2; ++bj) { const float* p = xb + (size_t)(ai * 128 + m * 16) * DM + bj * 128; acc[ai][bj][m][0] = *(const f32x4*)p; acc[ai][bj][m][1] = *(const f32x4*)(p + 4); }
    }
    __device__ __forceinline__ void operator()(f32x4 (&acc)[2][2][4][2], const pg8::Unit& u, int wr, int wc, int fr, int fq) const {
        const int wid = wr * 4 + wc, lane = fq * 16 + fr;
        const int row0 = u.pm * 256 + wr * 64 + fr, c0 = u.pn * 256 + wc * 32 + 8 * fq;
        LAS float* P = (LAS float*)tb; LAS float* S = P + 1024; LAS unsigned* flag = (LAS unsigned*)(S + 256);
#pragma unroll
        for (int ai = 0; ai < 2; ++ai) {
#pragma unroll
            for (int m = 0; m < 4; ++m) { float s = 0.f;
#pragma unroll
                for (int bj = 0; bj < 2; ++bj)
#pragma unroll
                    for (int n = 0; n < 2; ++n) { const f32x4 v = acc[ai][bj][m][n]; s += (v[0] * v[0] + v[1] * v[1]) + (v[2] * v[2] + v[3] * v[3]); }
                s = xrow_sum(s);
                if (fq == 0) P[(ai * 128 + wr * 64 + m * 16 + fr) * 4 + wc] = s; }
            asm volatile("" ::: "memory");
        }
        LDS_BARRIER();
        const int row = wid * 32 + (lane & 31);
        if (lane < 32) { const f32x4 p = *(const LAS f32x4*)(P + row * 4);
            __hip_atomic_store(xbuf + ((size_t)(u.pm * 256 + row) * 4 + u.pn), __float_as_uint((p[0] + p[1]) + (p[2] + p[3])), RLX_AGENT); }
        VM_WAIT();
        if (lane == 0) __hip_atomic_fetch_add(cnt + 32 * u.pm, 1u, RLX_AGENT);
        if (wid == 0) {
            bool dead = false; unsigned sp = 0;
            while ((unsigned)__builtin_amdgcn_readfirstlane(__hip_atomic_load(cnt + 32 * u.pm, RLX_AGENT)) < 32u) {
                __builtin_amdgcn_s_sleep(2);
                if (++sp > (1u << 22)) { dead = true; break; } }
            if (dead && lane == 0) __hip_atomic_store(tmo, 1u, RLX_AGENT);
            __builtin_amdgcn_fence(__ATOMIC_ACQUIRE, "agent");
            if (lane == 0) flag[0] = dead ? 1u : 0u;
        }
        asm volatile("s_waitcnt vmcnt(0) lgkmcnt(0)\n\ts_barrier" ::: "memory");
        const bool bad = flag[0] != 0u;
        if (lane < 32) { const unsigned* sl = xbuf + (size_t)(u.pm * 256 + row) * 4;
            const float t0 = __uint_as_float(__hip_atomic_load(sl + 0, RLX_AGENT)), t1 = __uint_as_float(__hip_atomic_load(sl + 1, RLX_AGENT));
            const float t2 = __uint_as_float(__hip_atomic_load(sl + 2, RLX_AGENT)), t3 = __uint_as_float(__hip_atomic_load(sl + 3, RLX_AGENT));
            float rs = 1.f / sqrtf(((t0 + t1) + (t2 + t3)) * (1.f / DM) + 1e-6f);
            if (bad) rs = __builtin_nanf("");
            S[row] = rs; }
        LDS_BARRIER();
        f32x4 g[2][2];
#pragma unroll
        for (int bj = 0; bj < 2; ++bj) { g[bj][0] = *(const f32x4*)(gw + c0 + bj * 128); g[bj][1] = *(const f32x4*)(gw + c0 + bj * 128 + 4); }
        float* ob = out + (size_t)row0 * DM + c0;
#pragma unroll
        for (int ai = 0; ai < 2; ++ai) {
#pragma unroll
            for (int m = 0; m < 4; ++m) { const float rs = S[ai * 128 + wr * 64 + m * 16 + fr];
#pragma unroll
                for (int bj = 0; bj < 2; ++bj) { float* o = ob + (size_t)(ai * 128 + m * 16) * DM + bj * 128;
                    *(f32x4*)o = acc[ai][bj][m][0] * rs * g[bj][0]; *(f32x4*)(o + 4) = acc[ai][bj][m][1] * rs * g[bj][1]; } }
            asm volatile("" ::: "memory");
        }
    }
};
template <int ACT> struct EpiCmp {
    static constexpr bool PERM = true, INIT = false;
    bf16_t* O; int ldc; const float* bias; int bstride; int ncols;
    __device__ __forceinline__ void operator()(const f32x4 (&acc)[2][2][4][2], const pg8::Unit& u, int wr, int wc, int fr, int fq) const {
#pragma unroll
        for (int bj = 0; bj < 2; ++bj) {
            const int c = bj * 128 + wc * 32 + 8 * fq;
            if (c < ncols) {
                const f32x4 b0 = *(const f32x4*)(bias + u.pn * bstride + c), b1 = *(const f32x4*)(bias + u.pn * bstride + c + 4);
#pragma unroll
                for (int ai = 0; ai < 2; ++ai)
#pragma unroll
                    for (int m = 0; m < 4; ++m) {
                        const size_t row = (size_t)u.pm * 256 + ai * 128 + wr * 64 + m * 16 + fr;
                        f32x4 v0 = acc[ai][bj][m][0] + b0, v1 = acc[ai][bj][m][1] + b1;
                        if (ACT == 1) {
#pragma unroll
                            for (int e = 0; e < 4; ++e) { v0[e] = gelu_f(v0[e]); v1[e] = gelu_f(v1[e]); }
                        }
                        st_bf16x8(O + row * ldc + c, v0, v1);
                    }
            }
        }
    }
};

#define XB_TMO      128
#define XB_XCNT(j)  (256  + 64 * (j))
#define XB_XSUB(j)  (1280 + 64 * (j))
#define XB_XGEN(j)  (2304 + 64 * (j))
#define XB_TOP      3328
#define XB_TOPGEN   3392
#define XCD_BAR_WORDS 3456
#define XB_SPIN_CAP (1u << 18)
__device__ __forceinline__ unsigned xb_ld(unsigned* p)              { return __hip_atomic_load(p, __ATOMIC_RELAXED, __HIP_MEMORY_SCOPE_AGENT); }
__device__ __forceinline__ unsigned xb_add(unsigned* p, unsigned v) { return __hip_atomic_fetch_add(p, v, __ATOMIC_RELAXED, __HIP_MEMORY_SCOPE_AGENT); }
__device__ __forceinline__ unsigned xb_xcc_id() { return (unsigned)__builtin_amdgcn_s_getreg((3 << 11) | 20) & 0xFu; }
#define XB_SPIN(cond, bar) do { unsigned _sp = 0; while (cond) { __builtin_amdgcn_s_sleep(1); \
    if ((++_sp & 255u) == 0u) { if (xb_ld(&(bar)[XB_TMO])) break; if (_sp > XB_SPIN_CAP) { atomicAdd(&(bar)[XB_TMO], 1u); break; } } } } while (0)
struct XcdBarrier { unsigned* bar; unsigned x; volatile LAS unsigned* st; };
__device__ __forceinline__ XcdBarrier xcd_barrier_post(unsigned* bar, volatile LAS unsigned* st) {
    XcdBarrier b; b.bar = bar; b.x = xb_xcc_id(); b.st = st;
    if (threadIdx.x == 0) (void)xb_add(&bar[XB_XCNT(b.x)], 1u);
    return b;
}
__device__ __forceinline__ void xcd_barrier_complete(unsigned* bar, unsigned x, unsigned& nloc, unsigned& nx) {
    const unsigned G = gridDim.x * gridDim.y * gridDim.z;
    unsigned sum, cnt, mine, sp = 0u;
    for (;;) {
        sum = 0u; cnt = 0u; mine = 0u;
#pragma unroll
        for (unsigned j = 0; j < 16; ++j) { const unsigned c = xb_ld(&bar[XB_XCNT(j)]); sum += c; cnt += (c > 0u) ? 1u : 0u; mine = (j == x) ? c : mine; }
        if (sum == G) break;
        __builtin_amdgcn_s_sleep(1);
        if ((++sp & 255u) == 0u) { if (xb_ld(&bar[XB_TMO])) break; if (sp > XB_SPIN_CAP) { atomicAdd(&bar[XB_TMO], 1u); break; } }
    }
    nloc = mine > 0u ? mine : 1u; nx = cnt > 0u ? cnt : 1u;
}
__device__ __forceinline__ void xcd_barrier(const XcdBarrier& b) {
    asm volatile("s_waitcnt vmcnt(0)" ::: "memory");
    __syncthreads();
    if (threadIdx.x == 0) {
        unsigned* bar = b.bar;
        __builtin_amdgcn_s_waitcnt(0);
        unsigned nloc = b.st[0], nx = b.st[1];
        if (nloc == 0u) { xcd_barrier_complete(bar, b.x, nloc, nx); b.st[0] = nloc; b.st[1] = nx; }
        const unsigned old = xb_add(&bar[XB_XSUB(b.x)], 1u);
        const unsigned gen = old / nloc;
        if (old + 1u == (gen + 1u) * nloc) {
            __builtin_amdgcn_fence(__ATOMIC_RELEASE, "agent");
            asm volatile("s_waitcnt vmcnt(0)" ::: "memory");
            const unsigned og = xb_add(&bar[XB_TOP], 1u);
            const unsigned tg = og / nx;
            if (og + 1u == (tg + 1u) * nx) xb_add(&bar[XB_TOPGEN], 1u);
            else XB_SPIN(xb_ld(&bar[XB_TOPGEN]) == tg, bar);
            __builtin_amdgcn_fence(__ATOMIC_ACQUIRE, "agent");
            xb_add(&bar[XB_XGEN(b.x)], 1u);
            asm volatile("s_waitcnt vmcnt(0)" ::: "memory");
        } else {
            XB_SPIN(xb_ld(&bar[XB_XGEN(b.x)]) == gen, bar);
            __builtin_amdgcn_fence(__ATOMIC_ACQUIRE, "agent");
            asm volatile("s_waitcnt vmcnt(0)" ::: "memory");
        }
    }
    __syncthreads();
}

struct Frame {
    LAS unsigned char* lds;
    int tid, lane, wave, vcu, G, gw, NGW;
    const void* const* in;
    float* out; unsigned char* ws;
};
#define F_IN(T, i) ((const T*)F.in[i])
#define x_prompt   F_IN(float, 0)
#define x_sample   F_IN(float, 1)
#define cache_cmp  F_IN(float, 2)
#define cache_sel  F_IN(float, 3)
#define state_win  F_IN(float, 4)
#define page_table F_IN(int, 5)
#define norm_g     F_IN(float, 6)
#define w_in       F_IN(float, 7)
#define ln_v_g     F_IN(float, 8)
#define spatial_w  F_IN(float, 9)
#define spatial_b  F_IN(float, 10)
#define cmp_pe     F_IN(float, 11)
#define cmp_w1     F_IN(float, 12)
#define cmp_b1     F_IN(float, 13)
#define cmp_w2     F_IN(float, 14)
#define cmp_b2     F_IN(float, 15)
#define rel_table  F_IN(float, 16)
#define w_out      F_IN(float, 17)
#define final_g    F_IN(float, 18)
#define WSP(T, off) ((T*)(F.ws + (off)))
#define WinT  WSP(bf16_t, WS_WIN)
#define WoutT WSP(bf16_t, WS_WOUT)
#define W1T   WSP(bf16_t, WS_W1T)
#define W2T   WSP(bf16_t, WS_W2T)
#define SW    WSP(bf16_t, WS_SW)
#define HB    WSP(float, WS_HB)
#define GATES WSP(float, WS_GATES)
#define H     WSP(bf16_t, WS_H)
#define UA    WSP(bf16_t, WS_UA)
#define VG    WSP(bf16_t, WS_VG)
#define Q     WSP(bf16_t, WS_Q)
#define MIX   WSP(bf16_t, WS_MIX)
#define MIXO  WSP(bf16_t, WS_MIXO)
#define KVS   WSP(bf16_t, WS_KVS)
#define KVW   WSP(bf16_t, WS_KVW)
#define AC    WSP(bf16_t, WS_AC)
#define HC    WSP(bf16_t, WS_HC)
#define KC    WSP(bf16_t, WS_KC)
#define KCS   WSP(bf16_t, WS_KCS)
#define HCS   WSP(bf16_t, WS_HCS)
#define ACS   WSP(bf16_t, WS_ACS)

__device__ const unsigned char T5_BUCKET[128] = {
    0, 1, 2, 3, 4, 5, 6, 7, 8, 9, 10, 11, 12, 13, 14, 15, 16, 16, 16, 17, 17, 18, 18, 18, 19, 19, 19, 20, 20, 20, 20, 21, 21, 21, 21, 22, 22, 22, 22, 22, 23, 23, 23, 23, 23, 23, 24, 24, 24, 24, 24, 24,
    25, 25, 25, 25, 25, 25, 25, 26, 26, 26, 26, 26, 26, 26, 26, 27, 27, 27, 27, 27, 27, 27, 27, 27, 27, 28, 28, 28, 28, 28, 28, 28, 28, 28, 28, 29, 29, 29, 29, 29, 29, 29, 29, 29, 29, 29, 29,
    30, 30, 30, 30, 30, 30, 30, 30, 30, 30, 30, 30, 30, 30, 31, 31, 31, 31, 31, 31, 31, 31, 31, 31, 31, 31, 31, 31, 31};

__device__ __forceinline__ void transpose_item(const float* W, int ldw, int K, bf16_t* WT, int k0, int c0, int r0, int cvalid, LAS float* scr, int lane) {
#pragma unroll 8
    for (int i = 0; i < 32; ++i) { const int kk = 2 * i + (lane >> 5), cc = lane & 31; scr[kk * 33 + cc] = (cc < cvalid) ? W[(size_t)(k0 + kk) * ldw + c0 + cc] : 0.f; }
    LDS_WAIT(); asm volatile("" ::: "memory");
    const int c = lane & 7;
#pragma unroll
    for (int j = 0; j < 4; ++j) { const int n = (lane >> 3) + 8 * j; const LAS float* s = scr + (8 * c) * 33 + n;
        u32x4 o; o.x = pk2(s[0 * 33], s[1 * 33]); o.y = pk2(s[2 * 33], s[3 * 33]); o.z = pk2(s[4 * 33], s[5 * 33]); o.w = pk2(s[6 * 33], s[7 * 33]);
        *(u32x4*)(WT + (size_t)(r0 + n) * K + k0 + 8 * c) = o; }
    LDS_WAIT(); asm volatile("" ::: "memory");
}

__device__ __forceinline__ void convert_rows(Frame& F, int m) {
    const int lane = F.lane, b = m >> 3, g = (m >> 2) & 1, nq = m & 3;
    const int nci = (nq == 3) ? 256 : 257;
    for (int c0 = F.wave; c0 < nci; c0 += 16) {
        const int c1 = (c0 + 8 < nci) ? c0 + 8 : c0;
        const int n0 = 256 * nq + c0, n1 = 256 * nq + c1;
        const int ph0 = page_table[b * NPAGES + (n0 >> 3)], ph1 = page_table[b * NPAGES + (n1 >> 3)];
        const float* s0 = cache_cmp + ((size_t)ph0 * PAGE + (n0 & 7) * 16) * 256 + g * 64;
        const float* s1 = cache_cmp + ((size_t)ph1 * PAGE + (n1 & 7) * 16) * 256 + g * 64;
        bf16_t* d0 = ACS + ((size_t)((b * 2 + g) * NCS + n0)) * 1024;
        bf16_t* d1 = ACS + ((size_t)((b * 2 + g) * NCS + n1)) * 1024;
        f32x4 v0[8], v1[8];
#pragma unroll
        for (int i = 0; i < 8; ++i) { const int idx = i * 64 + lane, kv = idx >> 8, l = (idx >> 4) & 15, d4 = idx & 15; const size_t so = (size_t)l * 256 + kv * 128 + d4 * 4;
            v0[i] = __builtin_nontemporal_load((const f32x4*)(s0 + so)); v1[i] = __builtin_nontemporal_load((const f32x4*)(s1 + so)); }
#pragma unroll
        for (int i = 0; i < 8; ++i) { const int idx = i * 64 + lane, kv = idx >> 8, l = (idx >> 4) & 15, d4 = idx & 15; const size_t dof = (size_t)kv * DB * 2 * NCS * 1024 + l * 64 + d4 * 4;
            u32x2 o; o.x = pk2(v0[i][0], v0[i][1]); o.y = pk2(v0[i][2], v0[i][3]); *(u32x2*)(d0 + dof) = o;
            u32x2 p; p.x = pk2(v1[i][0], v1[i][1]); p.y = pk2(v1[i][2], v1[i][3]); *(u32x2*)(d1 + dof) = p; }
    }
}

__device__ __forceinline__ void p0_prologue(Frame& F) {
    LAS float* scr = (LAS float*)(F.lds + F.wave * 16384);
    const int gw = F.gw, NGW = F.NGW, lane = F.lane;
    constexpr int I_IN = 16 * (NPAD / 32), I_OUT = 16 * 32, I_W1 = 2 * 32 * 8, I_W2 = 2 * 4 * 8;
    constexpr int NITEMS = I_IN + I_OUT + I_W1 + I_W2;
    for (int it = gw; it < NITEMS; it += NGW) {
        int r = it;
        if (r < I_IN) { const int kb = r / (NPAD / 32), nb = r % (NPAD / 32), r0 = nb * 32; int c0, cv;
            if (r0 < 2816) { c0 = r0; cv = 32; } else if (r0 < 3328) { c0 = r0 + 24; cv = 32; } else if (r0 == 3328) { c0 = 2816; cv = 24; } else { c0 = 0; cv = 0; }
            transpose_item(w_in, D_IN, DM, WinT, kb * 64, c0, r0, cv, scr, lane); continue; }
        r -= I_IN;
        if (r < I_OUT) { transpose_item(w_out, DM, DM, WoutT, (r / 32) * 64, (r % 32) * 32, (r % 32) * 32, 32, scr, lane); continue; }
        r -= I_OUT;
        if (r < I_W1) { const int kv = r / 256, q = r % 256;
            transpose_item(cmp_w1 + (size_t)kv * 2048 * 256, 256, 2048, W1T + (size_t)kv * 256 * 2048, (q / 8) * 64, (q % 8) * 32, (q % 8) * 32, 32, scr, lane); continue; }
        r -= I_W1;
        { const int kv = r / 32, q = r % 32, nb = q % 8;
          transpose_item(cmp_w2 + (size_t)kv * 256 * 64, 64, 256, W2T + (size_t)kv * 256 * 256, (q / 8) * 64, (nb < 2 ? nb * 32 : 0), nb * 32, (nb < 2 ? 32 : 0), scr, lane); }
    }
    for (int i = gw * 64 + lane; i < 8 * 128 * 128; i += NGW * 64) { const int s = i & 127, t = (i >> 7) & 127; SW[i] = (bf16_t)f2bf(s <= t ? spatial_w[i] : 0.f); }
    if (gw < 512) { const int o = gw, kv = o >> 8, h = o & 255; const float* w = cmp_w1 + (size_t)kv * 2048 * 256 + h; const float* pe = cmp_pe + kv * 2048; float a = 0.f;
#pragma unroll 8
        for (int k = lane; k < 2048; k += 64) a += pe[k] * w[(size_t)k * 256];
        a = wave_sum(a);
        if (lane == 0) HB[o] = a + cmp_b1[o]; }
    for (int m = gw; m < MT; m += 2 * NGW) {
        const int m2 = (m + NGW < MT) ? m + NGW : m;
        const float* xa = (m < MP) ? x_prompt + (size_t)m * DM : x_sample + (size_t)(m - MP) * DM;
        const float* xb = (m2 < MP) ? x_prompt + (size_t)m2 * DM : x_sample + (size_t)(m2 - MP) * DM;
        f32x4 va[4], vb[4]; float sa = 0.f, sb = 0.f;
#pragma unroll
        for (int j = 0; j < 4; ++j) { va[j] = *(const f32x4*)(xa + 256 * j + 4 * lane); vb[j] = *(const f32x4*)(xb + 256 * j + 4 * lane); }
#pragma unroll
        for (int j = 0; j < 4; ++j) { sa += (va[j][0] * va[j][0] + va[j][1] * va[j][1]) + (va[j][2] * va[j][2] + va[j][3] * va[j][3]);
            sb += (vb[j][0] * vb[j][0] + vb[j][1] * vb[j][1]) + (vb[j][2] * vb[j][2] + vb[j][3] * vb[j][3]); }
        const float ra = 1.f / sqrtf(wave_sum(sa) * (1.f / DM) + 1e-6f), rb = 1.f / sqrtf(wave_sum(sb) * (1.f / DM) + 1e-6f);
#pragma unroll
        for (int j = 0; j < 4; ++j) { const f32x4 g = *(const f32x4*)(norm_g + 256 * j + 4 * lane);
            u32x2 o; o.x = pk2(va[j][0] * ra * g[0], va[j][1] * ra * g[1]); o.y = pk2(va[j][2] * ra * g[2], va[j][3] * ra * g[3]);
            *(u32x2*)(H + (size_t)m * DM + 256 * j + 4 * lane) = o;
            u32x2 p; p.x = pk2(vb[j][0] * rb * g[0], vb[j][1] * rb * g[1]); p.y = pk2(vb[j][2] * rb * g[2], vb[j][3] * rb * g[3]);
            *(u32x2*)(H + (size_t)m2 * DM + 256 * j + 4 * lane) = p; }
    }
    for (int i = gw * 64 + lane; i < DB * 504 * 64; i += NGW * 64) { const int b = i / (504 * 64), r = i % (504 * 64);
        *(f32x4*)(F.out + O_WS + (size_t)b * 512 * 256 + (size_t)r * 4) = *(const f32x4*)(state_win + (size_t)b * 512 * 256 + 8 * 256 + (size_t)r * 4); }
}

__device__ __forceinline__ float oct_sum(float v) {
    v += __builtin_bit_cast(float, __builtin_amdgcn_update_dpp(0, __builtin_bit_cast(int, v), 0xB1, 0xF, 0xF, true));
    v += __builtin_bit_cast(float, __builtin_amdgcn_update_dpp(0, __builtin_bit_cast(int, v), 0x4E, 0xF, 0xF, true));
    v += __builtin_bit_cast(float, __builtin_amdgcn_update_dpp(0, __builtin_bit_cast(int, v), 0x141, 0xF, 0xF, true));
    return v;
}
__device__ __forceinline__ s16x4 vtr(const LAS char* p) { return __builtin_bit_cast(s16x4, __builtin_amdgcn_ds_read_tr16_b64_v4i16((LAS s16x4*)p)); }

__device__ __forceinline__ void spatial_task(Frame& F, int chunk, int g, LAS char* vt) {
    const int lane = F.lane, h = lane >> 4, i16 = lane & 15;
    const size_t r0 = (size_t)chunk * 128;
    { const int ch = lane & 7;
      const f32x4 g0 = *(const f32x4*)(ln_v_g + g * 64 + ch * 8), g1 = *(const f32x4*)(ln_v_g + g * 64 + ch * 8 + 4);
#pragma unroll 4
      for (int i = 0; i < 16; ++i) { const int t = i * 8 + (lane >> 3);
          const u32x4 w = *(const u32x4*)(VG + (r0 + t) * 512 + g * 64 + ch * 8);
          float v[8] = {bflo(w.x), bfhi(w.x), bflo(w.y), bfhi(w.y), bflo(w.z), bfhi(w.z), bflo(w.w), bfhi(w.w)};
          float s = 0.f;
#pragma unroll
          for (int e = 0; e < 8; ++e) s += v[e];
          s = oct_sum(s);
          const float mu = s * (1.f / 64.f); float q = 0.f;
#pragma unroll
          for (int e = 0; e < 8; ++e) { v[e] -= mu; q += v[e] * v[e]; }
          q = oct_sum(q);
          const float rs = 1.f / sqrtf(q * (1.f / 64.f) + 1e-5f);
          u32x2 a, b; a.x = pk2(v[0] * rs * g0[0], v[1] * rs * g0[1]); a.y = pk2(v[2] * rs * g0[2], v[3] * rs * g0[3]);
          b.x = pk2(v[4] * rs * g1[0], v[5] * rs * g1[1]); b.y = pk2(v[6] * rs * g1[2], v[7] * rs * g1[3]);
          *(LAS u32x2*)(vt + t * SP_PITCH + ch * 16) = a; *(LAS u32x2*)(vt + t * SP_PITCH + ch * 16 + 8) = b; }
    }
    const bf16_t* Wg = SW + (size_t)g * 128 * 128;
    const LAS char* vb = vt + (8 * h + (i16 >> 2)) * SP_PITCH + (i16 & 3) * 8;
    f32x4 acc[8][4];
#pragma unroll
    for (int mt = 0; mt < 8; ++mt)
#pragma unroll
        for (int n = 0; n < 4; ++n) acc[mt][n] = (f32x4){0.f, 0.f, 0.f, 0.f};
#pragma unroll
    for (int ks = 0; ks < 4; ++ks) {
        bf16x8 wf[8];
#pragma unroll
        for (int mt = 2 * ks; mt < 8; ++mt) wf[mt] = *(const bf16x8*)(Wg + (size_t)(16 * mt + i16) * 128 + 32 * ks + 8 * h);
        bf16x8 vaf[4];
#pragma unroll
        for (int n = 0; n < 4; ++n) { const s16x4 lo = vtr(vb + (32 * ks) * SP_PITCH + n * 32), hi = vtr(vb + (32 * ks + 4) * SP_PITCH + n * 32);
            vaf[n] = (bf16x8){lo[0], lo[1], lo[2], lo[3], hi[0], hi[1], hi[2], hi[3]}; }
#pragma unroll
        for (int mt = 2 * ks; mt < 8; ++mt)
#pragma unroll
            for (int n = 0; n < 4; ++n) acc[mt][n] = __builtin_amdgcn_mfma_f32_16x16x32_bf16(vaf[n], wf[mt], acc[mt][n], 0, 0, 0);
    }
#pragma unroll
    for (int mt = 0; mt < 8; ++mt) { const int t = 16 * mt + i16; const float sb = spatial_b[g * 128 + t];
#pragma unroll
        for (int n = 0; n < 4; ++n) {
            const u32x2 uw = *(const u32x2*)(UA + (r0 + t) * 512 + g * 64 + 16 * n + 4 * h);
            const size_t mo = (r0 + t) * 1024 + g * 64 + 16 * n + 4 * h;
            const u32x2 zw = *(const u32x2*)(MIX + mo);
            u32x2 o; o.x = pk2(bflo(uw.x) * (acc[mt][n][0] + sb) * bflo(zw.x), bfhi(uw.x) * (acc[mt][n][1] + sb) * bfhi(zw.x));
            o.y = pk2(bflo(uw.y) * (acc[mt][n][2] + sb) * bflo(zw.y), bfhi(uw.y) * (acc[mt][n][3] + sb) * bfhi(zw.y));
            *(u32x2*)(MIXO + mo) = o; }
        asm volatile("" ::: "memory"); }
}
__device__ __forceinline__ void spatial_sample_task(Frame& F, int b, int g) {
    const int d = F.lane; const size_t r0 = (size_t)MP + b * 8;
    float va[8];
    const float lg = ln_v_g[g * 64 + d];
#pragma unroll
    for (int s = 0; s < 8; ++s) { const float v = bf2f(VG[(r0 + s) * 512 + g * 64 + d]); const float mu = wave_sum(v) * (1.f / 64.f); const float dv = v - mu;
        const float var = wave_sum(dv * dv) * (1.f / 64.f); va[s] = dv * (1.f / sqrtf(var + 1e-5f)) * lg;
        F.out[O_CV + ((size_t)b * 8 + s) * 512 + g * 64 + d] = va[s]; }
#pragma unroll
    for (int t = 0; t < 8; ++t) { float a = spatial_b[g * 128 + t];
#pragma unroll
        for (int s = 0; s <= t; ++s) a += spatial_w[((size_t)g * 128 + t) * 128 + s] * va[s];
        const float ua = bf2f(UA[(r0 + t) * 512 + g * 64 + d]);
        const size_t mo = (r0 + t) * 1024 + g * 64 + d;
        MIXO[mo] = (bf16_t)f2bf(ua * a * bf2f(MIX[mo])); }
}

struct SrcBf16 { const bf16_t* k; const bf16_t* v; int pitch; };
struct SrcF32 { const float* k; const float* v; int kmax; };

__device__ __forceinline__ void load_k(bf16x8 (&kf)[4][2], const SrcBf16& s, int lane) {
#pragma unroll
    for (int t = 0; t < 4; ++t)
#pragma unroll
        for (int ks = 0; ks < 2; ++ks) kf[t][ks] = *(const bf16x8*)(s.k + (size_t)(16 * t + (lane & 15)) * s.pitch + 32 * ks + 8 * (lane >> 4));
}
__device__ __forceinline__ void stage_v(LAS char* vs, const SrcBf16& s, int lane) {
#pragma unroll
    for (int c = 0; c < 8; ++c) { const int idx = c * 64 + lane, key = idx >> 3, ch = idx & 7;
        const u32x4 w = *(const u32x4*)(s.v + (size_t)key * s.pitch + ch * 8);
        *(LAS u32x4*)(vs + key * AW_VP + ch * 16) = w; }
}
__device__ __forceinline__ bf16x8 cvt8(const f32x4& a, const f32x4& b) {
    u32x4 w; w.x = pk2(a[0], a[1]); w.y = pk2(a[2], a[3]); w.z = pk2(b[0], b[1]); w.w = pk2(b[2], b[3]); return __builtin_bit_cast(bf16x8, w);
}
__device__ __forceinline__ void load_k(bf16x8 (&kf)[4][2], const SrcF32& s, int lane) {
#pragma unroll
    for (int t = 0; t < 4; ++t) { int kk = 16 * t + (lane & 15); kk = kk < s.kmax ? kk : s.kmax;
#pragma unroll
        for (int ks = 0; ks < 2; ++ks) { const float* p = s.k + (size_t)kk * 256 + 32 * ks + 8 * (lane >> 4); kf[t][ks] = cvt8(*(const f32x4*)p, *(const f32x4*)(p + 4)); } }
}
__device__ __forceinline__ void stage_v(LAS char* vs, const SrcF32& s, int lane) {
#pragma unroll
    for (int c = 0; c < 8; ++c) { const int idx = c * 64 + lane, key = idx >> 3, ch = idx & 7; const int kk = key < s.kmax ? key : s.kmax;
        const float* p = s.v + (size_t)kk * 256 + ch * 8;
        *(LAS bf16x8*)(vs + key * AW_VP + ch * 16) = cvt8(*(const f32x4*)p, *(const f32x4*)(p + 4));
        if (c == 3) __builtin_amdgcn_sched_barrier(0); }
}
typedef f32x4 Sc4[4];
template <int STRIDE>
__device__ __forceinline__ void qk_scores(Sc4& acc, const bf16x8 (&kf)[4][2], const bf16x8 (&qf)[2], int D0, unsigned LIM, const LAS float* tbh, const LAS f32x4* t2h, int h, float mref, float bfar) {
    const bool far = __all(D0 < 0 || (D0 - 63 * STRIDE >= 128 && (unsigned)D0 < LIM));
    const float c0 = far ? (D0 < 0 ? -INFINITY : bfar - mref) : -mref;
    const f32x4 ci = {c0, c0, c0, c0};
    if (STRIDE == 1 && !far && __all(D0 < (int)LIM)) {
#pragma unroll
        for (int t = 0; t < 4; ++t) { int e = D0 - 16 * t - 4 * h; e = e < -1 ? -1 : e; e = e > 131 ? 131 : e;
            const f32x4 cz = t2h[e];
            acc[t] = cz - mref; }
#pragma unroll
        for (int t = 0; t < 4; ++t) { acc[t] = __builtin_amdgcn_mfma_f32_16x16x32_bf16(kf[t][0], qf[0], acc[t], 0, 0, 0);
            acc[t] = __builtin_amdgcn_mfma_f32_16x16x32_bf16(kf[t][1], qf[1], acc[t], 0, 0, 0); }
        return;
    }
    if (STRIDE == 1 && !far && __all(D0 < 0 || D0 - 63 >= 128)) {
#pragma unroll
        for (int t = 0; t < 4; ++t) { int x = D0 - 16 * t - 4 * h - (int)LIM; x = x < -1 ? -1 : x; x = x > 3 ? 3 : x; x = D0 < 0 ? 3 : x;
            const f32x4 cz = t2h[133 + x];
            acc[t] = cz - mref; }
#pragma unroll
        for (int t = 0; t < 4; ++t) { acc[t] = __builtin_amdgcn_mfma_f32_16x16x32_bf16(kf[t][0], qf[0], acc[t], 0, 0, 0);
            acc[t] = __builtin_amdgcn_mfma_f32_16x16x32_bf16(kf[t][1], qf[1], acc[t], 0, 0, 0); }
        return;
    }
#pragma unroll
    for (int t = 0; t < 4; ++t) { acc[t] = __builtin_amdgcn_mfma_f32_16x16x32_bf16(kf[t][0], qf[0], ci, 0, 0, 0);
        acc[t] = __builtin_amdgcn_mfma_f32_16x16x32_bf16(kf[t][1], qf[1], acc[t], 0, 0, 0); }
    if (!far) {
#pragma unroll
        for (int t = 0; t < 4; ++t)
#pragma unroll
            for (int r = 0; r < 4; ++r) { const int kk = 16 * t + 4 * h + r; const int dist = D0 - STRIDE * kk;
                int dc = dist < 0 ? 0 : dist; dc = dc > 128 ? 128 : dc;
                const float v = acc[t][r] + tbh[dc * 8];
                acc[t][r] = ((unsigned)dist < LIM) ? v : -INFINITY; }
    }
}
__device__ __forceinline__ float quad_sum(float v) {
    v += __builtin_bit_cast(float, __builtin_amdgcn_update_dpp(0, __builtin_bit_cast(int, v), 0xB1, 0xF, 0xF, true));
    v += __builtin_bit_cast(float, __builtin_amdgcn_update_dpp(0, __builtin_bit_cast(int, v), 0x4E, 0xF, 0xF, true));
    return v;
}
__device__ __forceinline__ float xrow_max(float m) {
    auto a = __builtin_amdgcn_permlane16_swap(__float_as_uint(m), __float_as_uint(m), false, false); m = fmaxf(__uint_as_float(a[0]), __uint_as_float(a[1]));
    auto c = __builtin_amdgcn_permlane32_swap(__float_as_uint(m), __float_as_uint(m), false, false); return fmaxf(__uint_as_float(c[0]), __uint_as_float(c[1]));
}
__device__ __forceinline__ float xrow_sum(float m) {
    auto a = __builtin_amdgcn_permlane16_swap(__float_as_uint(m), __float_as_uint(m), false, false); m = __uint_as_float(a[0]) + __uint_as_float(a[1]);
    auto c = __builtin_amdgcn_permlane32_swap(__float_as_uint(m), __float_as_uint(m), false, false); return __uint_as_float(c[0]) + __uint_as_float(c[1]);
}
__device__ __forceinline__ float max3f(float a, float b, float c) { float r; asm("v_max3_f32 %0, %1, %2, %3" : "=v"(r) : "v"(a), "v"(b), "v"(c)); return r; }
__device__ __forceinline__ float lane_max16(Sc4& s) {
    asm volatile("s_nop 7\n\ts_nop 3" : "+v"(s[0]), "+v"(s[1]), "+v"(s[2]), "+v"(s[3]));
    float a = max3f(s[0][0], s[0][1], s[0][2]), b = max3f(s[0][3], s[1][0], s[1][1]);
    a = max3f(a, s[1][2], s[1][3]); b = max3f(b, s[2][0], s[2][1]); a = max3f(a, s[2][2], s[2][3]); b = max3f(b, s[3][0], s[3][1]); a = max3f(a, s[3][2], s[3][3]);
    return max3f(a, b, b);
}
__device__ __forceinline__ float mref_of(float m) { return (m == -INFINITY) ? 0.f : m; }
struct SoftSt { float m; f32x4 l; f32x4 o[4]; };
__device__ __forceinline__ void soft_init(SoftSt& st) { st.m = -INFINITY; st.l = (f32x4){0.f, 0.f, 0.f, 0.f};
#pragma unroll
    for (int dt = 0; dt < 4; ++dt) st.o[dt] = (f32x4){0.f, 0.f, 0.f, 0.f}; }
__device__ __forceinline__ void pack_p(bf16x8 (&pb)[2], const Sc4& p) {
#pragma unroll
    for (int s = 0; s < 2; ++s) { u32x4 w; w.x = pk2(p[2 * s][0], p[2 * s][1]); w.y = pk2(p[2 * s][2], p[2 * s][3]); w.z = pk2(p[2 * s + 1][0], p[2 * s + 1][1]); w.w = pk2(p[2 * s + 1][2], p[2 * s + 1][3]); pb[s] = __builtin_bit_cast(bf16x8, w); }
}
__device__ __forceinline__ void exp4(Sc4& s) {
#pragma unroll
    for (int t = 0; t < 4; ++t)
#pragma unroll
        for (int r = 0; r < 4; ++r) s[t][r] = __builtin_amdgcn_exp2f(s[t][r]);
}
__device__ __forceinline__ void sum_acc(f32x4& l, const bf16x8 (&pb)[2]) {
    const bf16x8 ones = {(short)0x3F80, (short)0x3F80, (short)0x3F80, (short)0x3F80, (short)0x3F80, (short)0x3F80, (short)0x3F80, (short)0x3F80};
    l = __builtin_amdgcn_mfma_f32_16x16x32_bf16(ones, pb[0], l, 0, 0, 0);
    l = __builtin_amdgcn_mfma_f32_16x16x32_bf16(ones, pb[1], l, 0, 0, 0);
}
__device__ __forceinline__ void load_vf(bf16x8 (&vf)[2][4], const LAS char* vs, int lane) {
    const int h = lane >> 4, i16 = lane & 15;
    const LAS char* vb = vs + (4 * h + (i16 >> 2)) * AW_VP + (i16 & 3) * 8;
#pragma unroll
    for (int s = 0; s < 2; ++s)
#pragma unroll
        for (int dt = 0; dt < 4; ++dt) {
            const s16x4 lo = vtr(vb + (32 * s) * AW_VP + dt * 32), hi = vtr(vb + (32 * s + 16) * AW_VP + dt * 32);
            vf[s][dt] = (bf16x8){lo[0], lo[1], lo[2], lo[3], hi[0], hi[1], hi[2], hi[3]};
        }
}
__device__ __forceinline__ void pv_acc(f32x4 (&o)[4], const bf16x8 (&pb)[2], const bf16x8 (&vf)[2][4]) {
#pragma unroll
    for (int s = 0; s < 2; ++s)
#pragma unroll
        for (int dt = 0; dt < 4; ++dt) o[dt] = __builtin_amdgcn_mfma_f32_16x16x32_bf16(vf[s][dt], pb[s], o[dt], 0, 0, 0);
}
template <bool WITH_O>
__device__ __forceinline__ void max_update(Sc4& s, SoftSt& st) {
    const float lm = lane_max16(s);
    const bool first = (st.m == -INFINITY);
    if (__any(lm > 8.f || (first && lm > -INFINITY))) {
        const float mb = xrow_max(lm);
        const float delta = first ? ((mb == -INFINITY) ? 0.f : mb) : fmaxf(mb, 0.f);
        st.m = first ? mb : st.m + delta;
        const float alpha = __builtin_amdgcn_exp2f(-delta);
        st.l = st.l * alpha;
        if (WITH_O) {
#pragma unroll
            for (int dt = 0; dt < 4; ++dt) st.o[dt] = st.o[dt] * alpha; }
#pragma unroll
        for (int t = 0; t < 4; ++t) s[t] = s[t] - delta;
    }
}
__device__ __forceinline__ void online_step(Sc4& s, SoftSt& st, const bf16x8 (&vf)[2][4]) {
    max_update<true>(s, st);
    exp4(s);
    bf16x8 pb[2]; pack_p(pb, s);
    sum_acc(st.l, pb);
    pv_acc(st.o, pb, vf);
}
__device__ __forceinline__ void stats_step(Sc4& s, SoftSt& st) {
    max_update<false>(s, st);
    exp4(s);
    const float a0 = (s[0][0] + s[0][1]) + (s[0][2] + s[0][3]), a1 = (s[1][0] + s[1][1]) + (s[1][2] + s[1][3]), a2 = (s[2][0] + s[2][1]) + (s[2][2] + s[2][3]), a3 = (s[3][0] + s[3][1]) + (s[3][2] + s[3][3]);
    const float t = xrow_sum((a0 + a1) + (a2 + a3));
    st.l = st.l + (f32x4){t, t, t, t};
}

__device__ __forceinline__ void attn_bias_table(Frame& F, LAS float* tb);
constexpr int CP_BUFSZ = 19456, CP_V = 9216, CP_KP = 144;
constexpr int CP_IMPG = 2 * CP_BUFSZ;
constexpr int CP_IMP = 4 * CP_BUFSZ, CP_IMPN = 132, CP_MSK = 7 * 16384, CP_TASK = CP_MSK + 1024;
static_assert(CP_IMP + 64 * CP_IMPN * 4 <= CP_MSK, "attention LDS map");
constexpr int LDS_XCH = LDS_TB + 4352;
constexpr int LDS_T2 = LDS_XCH + 3072, T2N = 138;
static_assert(CP_TASK + 64 <= LDS_TB && LDS_T2 + 8 * T2N * 16 <= LDS_MISC, "attention LDS map");

__device__ __forceinline__ void load_k_lds(bf16x8 (&kf)[4][2], const LAS char* kb, int lane) {
#pragma unroll
    for (int t = 0; t < 4; ++t)
#pragma unroll
        for (int ks = 0; ks < 2; ++ks) kf[t][ks] = *(const LAS bf16x8*)(kb + (16 * t + (lane & 15)) * CP_KP + ks * 64 + (lane >> 4) * 16);
}
template <int NW64>
__device__ __forceinline__ void topk_masks(const LAS float* iq, const LAS float* ip, int cur, LAS unsigned long long* mq, int lane) {
    unsigned key[NW64];
#pragma unroll
    for (int u = 0; u < NW64; ++u) { const int jj = 64 * u + lane; const bool cand = (jj >= 1 && jj <= cur - 2);
        float v = 0.f; if (cand) { v = iq[jj]; if (ip) v += ip[jj]; }
        key[u] = cand ? __float_as_uint(v) : 0u; }
    unsigned long long selm[NW64];
    if (cur >= 16) {
        unsigned T = 0u;
        for (int bit = 30; bit >= 0; --bit) { const unsigned trial = T | (1u << bit); int cnt = 0;
#pragma unroll
            for (int u = 0; u < NW64; ++u) cnt += __builtin_popcountll(__ballot(key[u] >= trial));
            if (cnt >= 13) { T = trial; if (cnt == 13) break; } }
        int c = 0;
#pragma unroll
        for (int u = 0; u < NW64; ++u) c += __builtin_popcountll(__ballot(key[u] > T));
        int needed = 13 - c, before = 0;
#pragma unroll
        for (int u = 0; u < NW64; ++u) { const int jj = 64 * u + lane;
            const bool cand = (jj >= 1 && jj <= cur - 2);
            const unsigned long long eqm = __ballot(cand && key[u] == T);
            const int pos = before + __builtin_popcountll(eqm & ((1ull << lane) - 1ull));
            const bool pick = cand && (key[u] > T || (key[u] == T && pos < needed));
            before += __builtin_popcountll(eqm);
            selm[u] = __ballot(pick || jj == 0 || (jj >= cur - 1 && jj <= cur)); }
    } else {
#pragma unroll
        for (int u = 0; u < NW64; ++u) selm[u] = __ballot(64 * u + lane <= cur);
    }
    if (lane == 0) {
#pragma unroll
        for (int u = 0; u < NW64; ++u) mq[u] = selm[u]; }
}
__device__ __forceinline__ unsigned long long uniform64(unsigned long long x) {
    return ((unsigned long long)__builtin_amdgcn_readfirstlane((unsigned)(x >> 32)) << 32) | (unsigned)__builtin_amdgcn_readfirstlane((unsigned)x);
}

constexpr int SEL_SLOT = 16384, SEL_NS = 7;
static_assert(SEL_NS * SEL_SLOT <= CP_MSK && 2 * SEL_SLOT <= CP_IMPG, "selected-branch ring");
__device__ __forceinline__ void sel_stage(LAS char* slot, const bf16_t* blk, int lane) {
    const int r8 = lane >> 3, pc = lane & 7;
#pragma unroll
    for (int i = 0; i < 8; ++i) {
        const int c = pc ^ ((4 * (i & 1)) | (r8 >> 1));
        const bf16_t* gp = blk + (size_t)(8 * i + r8) * 256 + c * 8;
        __builtin_amdgcn_global_load_lds((const unsigned*)gp, (LAS unsigned*)(slot + i * 1024), 16, 0, 0);
        __builtin_amdgcn_global_load_lds((const unsigned*)(gp + 128), (LAS unsigned*)(slot + 8192 + i * 1024), 16, 0, 0);
    }
}
__device__ __forceinline__ void load_k_sw(bf16x8 (&kf)[4][2], const LAS char* slot, int lane) {
    const int j16 = lane & 15, h = lane >> 4, sw = j16 >> 1;
#pragma unroll
    for (int t = 0; t < 4; ++t)
#pragma unroll
        for (int ks = 0; ks < 2; ++ks) kf[t][ks] = *(const LAS bf16x8*)(slot + (16 * t + j16) * 128 + (((4 * ks + h) ^ sw) << 4));
}
__device__ __forceinline__ void load_vf_sw(bf16x8 (&vf)[2][4], const LAS char* vs, int lane) {
    const int h = lane >> 4, i16 = lane & 15, sw = (2 * h + (i16 >> 3)) & 7;
    const LAS char* vb = vs + (4 * h + (i16 >> 2)) * 128 + (i16 & 1) * 8;
#pragma unroll
    for (int s = 0; s < 2; ++s)
#pragma unroll
        for (int dt = 0; dt < 4; ++dt) { const int po = ((2 * dt + ((i16 >> 1) & 1)) ^ sw) << 4;
            const s16x4 lo = vtr(vb + (32 * s) * 128 + po), hi = vtr(vb + (32 * s + 16) * 128 + po);
            vf[s][dt] = (bf16x8){lo[0], lo[1], lo[2], lo[3], hi[0], hi[1], hi[2], hi[3]};
        }
}
__device__ __forceinline__ void lds_spin_ge(const volatile LAS unsigned* p, unsigned want) {
    unsigned sp = 0;
    while ((unsigned)__builtin_amdgcn_readfirstlane((int)*p) < want) { __builtin_amdgcn_s_sleep(1); if (++sp > (1u << 20)) break; }
    asm volatile("" ::: "memory");
}
__device__ __forceinline__ void coop_prompt_task(Frame& F, int b, int g, int qblk, const LAS float* tb, const int var) {
    int tid = threadIdx.x; asm volatile("" : "+v"(tid));
    const int lane = tid & 63, w = F.wave, h = lane >> 4, j = lane & 15, qq = j >> 2, r = j & 3;
    const int head = g * 4 + r, q0 = 64 * qblk;
    const LAS float* tbh = tb + head;
    const float bfar = tbh[128 * 8];
    LAS char* lds = (LAS char*)F.lds;
    const LAS f32x4* t2h = (const LAS f32x4*)(lds + LDS_T2) + head * T2N + 1;
    LAS float* imp = (LAS float*)(lds + CP_IMP);
    LAS unsigned long long* msk = (LAS unsigned long long*)(lds + CP_MSK);
    int myq[2]; bf16x8 qf[2][2];
#pragma unroll
    for (int s = 0; s < 2; ++s) { myq[s] = q0 + 8 * w + 4 * s + qq;
#pragma unroll
        for (int ks = 0; ks < 2; ++ks) qf[s][ks] = *(const bf16x8*)(Q + ((size_t)b * SEQ + myq[s]) * 512 + head * 64 + 32 * ks + 8 * h); }
#define MYROW(s) ((size_t)b * SEQ + myq[s])
#define RBASE(s) (WSP(float, WS_DBG) + MYROW(s) * 512 + head * 64 + 4 * h)
#define GATE(s, br) (GATES[MYROW(s) * 24 + head * 3 + (br)])
    const int skey = tid >> 3, sch = tid & 7;
    __syncthreads();
    volatile LAS unsigned* rdy = (volatile LAS unsigned*)(lds + LDS_XCH); LAS unsigned* dn = (LAS unsigned*)(lds + LDS_XCH) + 128;
    if (tid < 256) rdy[tid] = 0u;
    int step = 0;
    bf16x8 kf[4][2]; Sc4 sc; u32x4 rk, rv;
    SoftSt st[2];
    const bf16_t* kc = KC + ((size_t)(b * 2 + g) * 512) * 64; const bf16_t* vc = kc + (size_t)NB * 2 * 512 * 64;
    const int ncb = ((4 * qblk + 3) >> 6) + 1;
    soft_init(st[0]); soft_init(st[1]);
    rk = *(const u32x4*)(kc + (size_t)skey * 64 + sch * 8);
    rv = *(const u32x4*)(vc + (size_t)skey * 64 + sch * 8);
    for (int cb = 0; cb < ncb; ++cb) {
        LAS char* buf = lds + (step & 1) * CP_BUFSZ; ++step;
        *(LAS u32x4*)(buf + skey * CP_KP + sch * 16) = rk;
        rk = *(const u32x4*)(kc + (size_t)(64 * (cb + 1 < ncb ? cb + 1 : 0) + skey) * 64 + sch * 8);
        LDS_BARRIER();
        load_k_lds(kf, buf, lane);
#pragma unroll
        for (int s = 0; s < 2; ++s) {
            qk_scores<16>(sc, kf, qf[s], myq[s] - 31 - 1024 * cb, 0x7fffffffu, tbh, t2h, h, mref_of(st[s].m), bfar);
            stats_step(sc, st[s]);
        }
    }
    {
        float mr2[2];
#pragma unroll
        for (int s = 0; s < 2; ++s) { const float l = st[s].l[0]; mr2[s] = (l > 0.f) ? st[s].m + __builtin_amdgcn_logf(l) : 0.f;
#pragma unroll
            for (int dt = 0; dt < 4; ++dt) st[s].o[dt] = (f32x4){0.f, 0.f, 0.f, 0.f}; }
        const bf16_t* kw0 = KVW + ((size_t)b * SEQ + skey) * 256 + g * 64 + sch * 8 + (size_t)(qblk >= 8 ? qblk - 8 : 0) * 64 * 256;
        for (int cb = 0; cb < ncb; ++cb) {
            LAS char* buf = lds + (step & 1) * CP_BUFSZ; ++step;
            *(LAS u32x4*)(buf + skey * CP_KP + sch * 16) = rk; *(LAS u32x4*)(buf + CP_V + skey * AW_VP + sch * 16) = rv;
            if (cb + 1 < ncb) { rk = *(const u32x4*)(kc + (size_t)(64 * (cb + 1) + skey) * 64 + sch * 8); rv = *(const u32x4*)(vc + (size_t)(64 * (cb + 1) + skey) * 64 + sch * 8); }
            else { rk = *(const u32x4*)kw0; rv = *(const u32x4*)(kw0 + 128); }
            LDS_BARRIER();
            load_k_lds(kf, buf, lane);
            bf16x8 vf[2][4]; load_vf(vf, buf + CP_V, lane);
            __builtin_amdgcn_sched_barrier(0);
#pragma unroll
            for (int s = 0; s < 2; ++s) {
                qk_scores<16>(sc, kf, qf[s], myq[s] - 31 - 1024 * cb, 0x7fffffffu, tbh, t2h, h, mr2[s], bfar);
                exp4(sc);
                bf16x8 pb[2]; pack_p(pb, sc);
                pv_acc(st[s].o, pb, vf);
                LAS float* ig = (LAS float*)(lds + CP_IMPG) + (8 * w + 4 * s + qq) * CP_IMPN; LAS float* ip = imp + (8 * w + 4 * s + qq) * CP_IMPN;
#pragma unroll
                for (int t = 0; t < 4; ++t) {
                    float gsum = (sc[t][0] + sc[t][1]) + (sc[t][2] + sc[t][3]), p3 = sc[t][3];
                    gsum = quad_sum(gsum); p3 = quad_sum(p3);
                    if (r == 0) { const int jb = 16 * cb + 4 * t + h; ig[jb] = gsum; ip[jb + 1] = p3; }
                }
            }
        }
#pragma unroll
        for (int s = 0; s < 2; ++s)
#pragma unroll
            for (int dt = 0; dt < 4; ++dt) *(f32x4*)(RBASE(s) + 16 * dt) = st[s].o[dt] * GATE(s, 0);
    }
    const bf16_t* kvs0 = KVS + (size_t)b * SEQ * 256 + g * 64;
    int pend = -1;
    LDS_BARRIER();
    if (w < 2 && w <= qblk) { sel_stage(lds + w * SEL_SLOT, kvs0 + (size_t)w * 64 * 256, lane); pend = w; }
    LDS_WAIT();
    for (int q8 = 0; q8 < 8; ++q8) topk_masks<2>((const LAS float*)(lds + CP_IMPG) + (8 * w + q8) * CP_IMPN, imp + (8 * w + q8) * CP_IMPN, qblk, msk + (8 * w + q8) * 2, lane);
    LDS_WAIT();
    unsigned long long un[2][2], mine[2];
#pragma unroll
    for (int s = 0; s < 2; ++s) {
#pragma unroll
        for (int u = 0; u < 2; ++u) { const LAS unsigned long long* mb = msk + (8 * w + 4 * s) * 2 + u; un[s][u] = uniform64(mb[0] | mb[2] | mb[4] | mb[6]); }
        mine[s] = msk[(8 * w + 4 * s + qq) * 2]; }
    {
        soft_init(st[0]); soft_init(st[1]);
        LDS_BARRIER();
        if (pend >= 0) { VM_WAIT(); if (lane == 0) rdy[pend] = 1u; pend = -1; }
        if (w == 2 && 2 <= qblk) { sel_stage(lds + 2 * SEL_SLOT, kvs0 + (size_t)2 * 64 * 256, lane); pend = 2; }
        int sj = 0, sjj = 3;
        for (int jb = 0; jb <= qblk; ++jb) {
            if (pend >= 0) { VM_WAIT(); if (lane == 0) rdy[pend] = 1u; pend = -1; }
            { const int jj = jb + 3;
              if (jj <= qblk && (jj & 7) == w) {
                  if (jj >= SEL_NS) lds_spin_ge(dn + (jj - SEL_NS), 8u);
                  sel_stage(lds + sjj * SEL_SLOT, kvs0 + (size_t)jj * 64 * 256, lane); pend = jj; } }
            if (jb == 64) { mine[0] = msk[(8 * w + qq) * 2 + 1]; mine[1] = msk[(8 * w + 4 + qq) * 2 + 1]; }
            const int u = jb >> 6, bit = jb & 63;
            const bool need0 = (un[0][u] >> bit) & 1ull, need1 = (un[1][u] >> bit) & 1ull;
            if (need0 || need1) {
                lds_spin_ge(rdy + jb, 1u);
                const LAS char* slot = lds + sj * SEL_SLOT;
                load_k_sw(kf, slot, lane);
                bf16x8 vf[2][4]; load_vf_sw(vf, slot + 8192, lane);
                LDS_WAIT();
                if (lane == 0) __hip_atomic_fetch_add(dn + jb, 1u, __ATOMIC_RELAXED, __HIP_MEMORY_SCOPE_WORKGROUP);
                __builtin_amdgcn_sched_barrier(0);
#pragma unroll
                for (int s = 0; s < 2; ++s) if (s == 0 ? need0 : need1) {
                    const int D0 = ((mine[s] >> bit) & 1ull) ? (myq[s] - 64 * jb) : -1;
                    qk_scores<1>(sc, kf, qf[s], D0, 0x7fffffffu, tbh, t2h, h, mref_of(st[s].m), bfar);
                    online_step(sc, st[s], vf);
                }
            } else if (lane == 0) __hip_atomic_fetch_add(dn + jb, 1u, __ATOMIC_RELAXED, __HIP_MEMORY_SCOPE_WORKGROUP);
            sj = (sj + 1 == SEL_NS) ? 0 : sj + 1; sjj = (sjj + 1 == SEL_NS) ? 0 : sjj + 1;
        }
#pragma unroll
        for (int s = 0; s < 2; ++s) { const float l = st[s].l[0]; const float f = GATE(s, 1) * (l > 0.f ? 1.f / l : 0.f);
#pragma unroll
            for (int dt = 0; dt < 4; ++dt) *(f32x4*)(RBASE(s) + 16 * dt) = *(const f32x4*)(RBASE(s) + 16 * dt) + st[s].o[dt] * f; }
        LDS_BARRIER();
    }
    {
        soft_init(st[0]); soft_init(st[1]);
        const int kb_lo = qblk >= 8 ? qblk - 8 : 0;
        const bf16_t* kb0 = KVW + ((size_t)b * SEQ + skey) * 256 + g * 64 + sch * 8;
        for (int kb = kb_lo; kb <= qblk; ++kb) {
            LAS char* buf = lds + (step & 1) * CP_BUFSZ; ++step;
            *(LAS u32x4*)(buf + skey * CP_KP + sch * 16) = rk; *(LAS u32x4*)(buf + CP_V + skey * AW_VP + sch * 16) = rv;
            if (kb < qblk) { const bf16_t* p = kb0 + (size_t)(kb + 1) * 64 * 256; rk = *(const u32x4*)p; rv = *(const u32x4*)(p + 128); }
            LDS_BARRIER();
            load_k_lds(kf, buf, lane);
            bf16x8 vf[2][4]; load_vf(vf, buf + CP_V, lane);
            __builtin_amdgcn_sched_barrier(0);
#pragma unroll
            for (int s = 0; s < 2; ++s) {
                qk_scores<1>(sc, kf, qf[s], myq[s] - 64 * kb, 512u, tbh, t2h, h, mref_of(st[s].m), bfar);
                online_step(sc, st[s], vf);
            }
        }
#pragma unroll
        for (int s = 0; s < 2; ++s) { const float l = st[s].l[0]; const float f = GATE(s, 2) * (l > 0.f ? 1.f / l : 0.f);
#pragma unroll
            for (int dt = 0; dt < 4; ++dt) {
                const f32x4 rv4 = *(const f32x4*)(RBASE(s) + 16 * dt) + st[s].o[dt] * f;
#ifdef ATTN_CHECK
                *(f32x4*)(RBASE(s) + 16 * dt) = rv4;
#endif
                const size_t mo = MYROW(s) * 1024 + 512 + head * 64 + 16 * dt + 4 * h;
                const u32x2 z = *(const u32x2*)(MIX + mo);
                u32x2 wv; wv.x = pk2(rv4[0] * bflo(z.x), rv4[1] * bfhi(z.x)); wv.y = pk2(rv4[2] * bflo(z.y), rv4[3] * bfhi(z.y));
                *(u32x2*)(MIXO + mo) = wv;
            } }
    }
#undef MYROW
#undef RBASE
#undef GATE
}

__device__ __forceinline__ void coop_sample_task(Frame& F, int b, int g, const LAS float* tb) {
    int tid_ = threadIdx.x; asm volatile("" : "+v"(tid_));
    const int lane = tid_ & 63, w = F.wave, h = lane >> 4, j = lane & 15, qq = j >> 2, r = j & 3;
    const int st = w & 1, wi = w >> 1;
    const int head = g * 4 + r, t0 = 4 * st, qpos0 = PAST + t0, myq = qpos0 + qq;
    const size_t myrow = (size_t)MP + b * 8 + t0 + qq;
    const LAS float* tbh = tb + head;
    const float bfar = tbh[128 * 8];
    LAS char* lds = (LAS char*)F.lds;
    const LAS f32x4* t2h = (const LAS f32x4*)(lds + LDS_T2) + head * T2N + 1;
    LAS char* vs = lds + w * AW_BYTES + AW_V;
    LAS float* imp = (LAS float*)(lds + st * AW_BYTES + AW_IMP);
    LAS float* impp = (LAS float*)(lds + (st + 2) * AW_BYTES + AW_IMP);
    LAS unsigned long long* msk = (LAS unsigned long long*)(lds + st * AW_BYTES + AW_MSK);
    LAS float* xch = (LAS float*)(lds + LDS_XCH);
    bf16x8 qf[2];
#pragma unroll
    for (int ks = 0; ks < 2; ++ks) qf[ks] = *(const bf16x8*)(Q + myrow * 512 + head * 64 + 32 * ks + 8 * h);
    const float* gp = GATES + myrow * 24 + head * 3;
    const float g_c = gp[0], g_s = gp[1], g_w = gp[2];
    __syncthreads();
    bf16x8 kf[4][2]; Sc4 sc;
    f32x4 res[4];
    const bf16_t* kc = KCS + ((size_t)(b * 2 + g) * NCS) * 64; const bf16_t* vc = kc + (size_t)DB * 2 * NCS * 64;
    const int Dc = myq - 31;
    SoftSt sc1; soft_init(sc1);
    for (int cb = wi; cb < 16; cb += 4) {
        SrcBf16 src{kc + (size_t)cb * 64 * 64, vc + (size_t)cb * 64 * 64, 64};
        load_k(kf, src, lane);
        qk_scores<16>(sc, kf, qf, Dc - 1024 * cb, 0x7fffffffu, tbh, t2h, h, mref_of(sc1.m), bfar);
        stats_step(sc, sc1);
    }
    if (h == 0) { xch[(w * 3 + 0) * 32 + j] = sc1.m; xch[(w * 3 + 0) * 32 + 16 + j] = sc1.l[0]; }
    __syncthreads();
    {
        float M = -INFINITY, L = 0.f;
#pragma unroll
        for (int k = 0; k < 4; ++k) M = fmaxf(M, xch[((st + 2 * k) * 3 + 0) * 32 + j]);
        const float Mu = (M == -INFINITY) ? 0.f : M;
#pragma unroll
        for (int k = 0; k < 4; ++k) L += xch[((st + 2 * k) * 3 + 0) * 32 + 16 + j] * __builtin_amdgcn_exp2f(xch[((st + 2 * k) * 3 + 0) * 32 + j] - Mu);
        const float mr2 = (L > 0.f) ? Mu + __builtin_amdgcn_logf(L) : 0.f;
        f32x4 o[4];
#pragma unroll
        for (int dt = 0; dt < 4; ++dt) o[dt] = (f32x4){0.f, 0.f, 0.f, 0.f};
        for (int cb = wi; cb < 16; cb += 4) {
            SrcBf16 src{kc + (size_t)cb * 64 * 64, vc + (size_t)cb * 64 * 64, 64};
            load_k(kf, src, lane); stage_v(vs, src, lane);
            qk_scores<16>(sc, kf, qf, Dc - 1024 * cb, 0x7fffffffu, tbh, t2h, h, mr2, bfar);
            exp4(sc);
            bf16x8 vf[2][4]; load_vf(vf, vs, lane);
            bf16x8 pb[2]; pack_p(pb, sc);
            pv_acc(o, pb, vf);
#pragma unroll
            for (int t = 0; t < 4; ++t) {
                float gsum = (sc[t][0] + sc[t][1]) + (sc[t][2] + sc[t][3]), p3 = sc[t][3];
                gsum = quad_sum(gsum); p3 = quad_sum(p3);
                if (r == 0) { const int jb = 16 * cb + 4 * t + h; imp[qq * AW_IMPN + jb] = gsum; impp[qq * AW_IMPN + jb + 1] = p3; }
            }
        }
#pragma unroll
        for (int dt = 0; dt < 4; ++dt) res[dt] = o[dt] * g_c;
    }
    __syncthreads();
    topk_masks<5>(imp + wi * AW_IMPN, impp + wi * AW_IMPN, 256, msk + wi * 8, lane);
    __syncthreads();
    SoftSt ss; soft_init(ss);
    {
        int cnt = 0;
#pragma unroll 1
        for (int u = 0; u < 5; ++u) {
            const unsigned long long mine = msk[qq * 8 + u];
            unsigned long long un = uniform64(msk[u] | msk[8 + u] | msk[16 + u] | msk[24 + u]);
            while (un) {
                const int bit = __builtin_ctzll(un); un &= un - 1; const int jb = 64 * u + bit;
                if (((cnt++) & 3) != wi) continue;
                const int D0 = ((mine >> bit) & 1ull) ? (myq - 64 * jb) : -1;
                SrcF32 src;
                if (jb < 256) { const int phys = page_table[b * NPAGES + (jb >> 1)]; src.k = cache_sel + ((size_t)phys * PAGE + (jb & 1) * 64) * 256 + g * 64; src.kmax = 63; }
                else { src.k = F.out + O_SS + (size_t)b * 8 * 256 + g * 64; src.kmax = 7; }
                src.v = src.k + 128;
                load_k(kf, src, lane); stage_v(vs, src, lane);
                bf16x8 vf[2][4]; load_vf(vf, vs, lane);
                qk_scores<1>(sc, kf, qf, D0, 0x7fffffffu, tbh, t2h, h, mref_of(ss.m), bfar);
                online_step(sc, ss, vf);
            }
        }
    }
    SoftSt sw; soft_init(sw);
    {
        const int tq = myq - PAST;
        for (int kb = wi; kb < 9; kb += 4) {
            SrcF32 src;
            if (kb < 8) { src.k = state_win + ((size_t)b * 512 + 64 * kb) * 256 + g * 64; src.kmax = 63; }
            else { src.k = F.out + O_WS + ((size_t)b * 512 + 504) * 256 + g * 64; src.kmax = 7; }
            src.v = src.k + 128;
            load_k(kf, src, lane); stage_v(vs, src, lane);
            bf16x8 vf[2][4]; load_vf(vf, vs, lane);
            qk_scores<1>(sc, kf, qf, 512 + tq - 64 * kb, 512u, tbh, t2h, h, mref_of(sw.m), bfar);
            online_step(sc, sw, vf);
        }
    }
    if (h == 0) { xch[(w * 3 + 1) * 32 + j] = ss.m; xch[(w * 3 + 1) * 32 + 16 + j] = ss.l[0]; xch[(w * 3 + 2) * 32 + j] = sw.m; xch[(w * 3 + 2) * 32 + 16 + j] = sw.l[0]; }
    __syncthreads();
#pragma unroll
    for (int br = 1; br < 3; ++br) {
        float M = -INFINITY, L = 0.f;
#pragma unroll
        for (int k = 0; k < 4; ++k) M = fmaxf(M, xch[((st + 2 * k) * 3 + br) * 32 + j]);
        const float Mu = (M == -INFINITY) ? 0.f : M;
#pragma unroll
        for (int k = 0; k < 4; ++k) L += xch[((st + 2 * k) * 3 + br) * 32 + 16 + j] * __builtin_amdgcn_exp2f(xch[((st + 2 * k) * 3 + br) * 32 + j] - Mu);
        const float f = (br == 1 ? g_s : g_w) * (L > 0.f ? 1.f / L : 0.f) * __builtin_amdgcn_exp2f((br == 1 ? ss.m : sw.m) - Mu);
#pragma unroll
        for (int dt = 0; dt < 4; ++dt) res[dt] = res[dt] + (br == 1 ? ss.o[dt] : sw.o[dt]) * f;
    }
#pragma unroll
    for (int dt = 0; dt < 4; ++dt) *(LAS f32x4*)(vs + (dt * 64 + lane) * 16) = res[dt];
    __syncthreads();
    if (wi == 0) {
#pragma unroll
        for (int dt = 0; dt < 4; ++dt) {
            f32x4 a = *(const LAS f32x4*)(lds + (st + 0) * AW_BYTES + AW_V + (dt * 64 + lane) * 16);
#pragma unroll
            for (int k = 1; k < 4; ++k) a = a + *(const LAS f32x4*)(lds + (st + 2 * k) * AW_BYTES + AW_V + (dt * 64 + lane) * 16);
#ifdef ATTN_CHECK
            *(f32x4*)(WSP(float, WS_DBG) + myrow * 512 + head * 64 + 16 * dt + 4 * h) = a;
#endif
            const size_t mo = myrow * 1024 + 512 + head * 64 + 16 * dt + 4 * h;
            const u32x2 z = *(const u32x2*)(MIX + mo);
            u32x2 wv; wv.x = pk2(a[0] * bflo(z.x), a[1] * bfhi(z.x)); wv.y = pk2(a[2] * bflo(z.y), a[3] * bfhi(z.y));
            *(u32x2*)(MIXO + mo) = wv;
        }
    }
}
constexpr int CW_QSP = 8192 + 64 * 9;
constexpr int CW_QHEAD = 8192, CW_QSAMP = 8192 + 64 * 8;
__device__ __forceinline__ void attn_phase(Frame& F, gu32* ctl, const int var, const int nsp) {
    LAS float* tb = (LAS float*)(F.lds + LDS_TB);
    attn_bias_table(F, tb);
    volatile LAS int* tsk = (volatile LAS int*)(F.lds + CP_TASK);
    const unsigned x = xb_xcc_id() & 7u;
    for (;;) {
        __syncthreads();
        if (F.tid == 0) { int idx = -1;
            if (__hip_atomic_load(ctl + CW_QSAMP, RLX_AGENT) < 64u) { const unsigned i = __hip_atomic_fetch_add(ctl + CW_QSAMP, 1u, RLX_AGENT); if (i < 64u) idx = (int)i; }
            tsk[0] = idx; }
        __syncthreads();
        const int idx = tsk[0];
        if (idx < 0) break;
        coop_sample_task(F, idx >> 1, idx & 1, tb);
    }
    for (;;) {
        __syncthreads();
        if (F.tid == 0) { int q = -1, idx = 0;
            for (unsigned tr = 0; tr < 8; ++tr) { const unsigned qq = (x + tr) & 7u;
                if (__hip_atomic_load(ctl + CW_QHEAD + 64 * qq, RLX_AGENT) >= 128u) continue;
                const unsigned i = __hip_atomic_fetch_add(ctl + CW_QHEAD + 64 * qq, 1u, RLX_AGENT);
                if (i < 128u) { q = (int)qq; idx = (int)i; break; } }
            tsk[0] = q; tsk[1] = idx; }
        __syncthreads();
        const int q = tsk[0], idx = tsk[1];
        if (q < 0) break;
        coop_prompt_task(F, q >> 1, q & 1, 127 - idx, tb, var);
    }
    for (;;) {
        __syncthreads();
        if (F.tid == 0) { int i = -1;
            if (__hip_atomic_load(ctl + CW_QSP, RLX_AGENT) < (unsigned)nsp) { const unsigned k = __hip_atomic_fetch_add(ctl + CW_QSP, 1u, RLX_AGENT); if (k < (unsigned)nsp) i = (int)k; }
            tsk[0] = i; }
        __syncthreads();
        const int i = tsk[0];
        if (i < 0) break;
        const int t2 = 1680 + 8 * i + F.wave;
        spatial_task(F, t2 >> 3, t2 & 7, (LAS char*)(F.lds + F.wave * SP_BYTES));
    }
}

#ifdef ATTN_CHECK
__device__ __forceinline__ int chk_bucket(int dist) { const int n = dist < 0 ? 0 : dist; if (n < 16) return n; const int large = 16 + (int)(logf((float)n / 16.f) / logf(8.f) * 16.f); return large < 31 ? large : 31; }
__device__ __forceinline__ float wave_max(float v) {
#pragma unroll
    for (int o = 1; o < 64; o <<= 1) v = fmaxf(v, __shfl_xor(v, o));
    return v;
}
__device__ const int CHK_SPECIAL[32] = {0, 1, 2, 3, 4, 15, 16, 29, 30, 31, 32, 33, 46, 47, 48, 62, 63, 64, 65, 100, 127, 128, 511, 512, 513, 700, 1023, 1024, 1025, 4095, 4096, 8191};
struct ChkCtx { bool sample; int b, g, qpos; };
__device__ __forceinline__ float chk_cmp_kv(Frame& F, const ChkCtx& c, int kv, int i, int d) {
    const bf16_t* base = c.sample ? KCS + (size_t)kv * DB * 2 * NCS * 64 + ((size_t)(c.b * 2 + c.g) * NCS + i) * 64 : KC + (size_t)kv * NB * 2 * 512 * 64 + ((size_t)(c.b * 2 + c.g) * 512 + i) * 64;
    return bf2f(base[d]);
}
__device__ __forceinline__ float chk_sel_kv(Frame& F, const ChkCtx& c, int kv, int pos, int d) {
    if (!c.sample) return bf2f(KVS[((size_t)c.b * SEQ + pos) * 256 + kv * 128 + c.g * 64 + d]);
    if (pos < PAST) { const int phys = page_table[c.b * NPAGES + (pos >> 7)]; return bf2f((bf16_t)f2bf(cache_sel[((size_t)phys * PAGE + (pos & 127)) * 256 + kv * 128 + c.g * 64 + d])); }
    const int t = pos - PAST; if (t >= DS) return 0.f;
    return bf2f((bf16_t)f2bf(F.out[O_SS + ((size_t)c.b * DS + t) * 256 + kv * 128 + c.g * 64 + d]));
}
__device__ __forceinline__ float chk_win_kv(Frame& F, const ChkCtx& c, int kv, int pos, int d) {
    if (!c.sample) return bf2f(KVW[((size_t)c.b * SEQ + pos) * 256 + kv * 128 + c.g * 64 + d]);
    const int k = pos - (PAST - 512);
    if (k < 512) return bf2f((bf16_t)f2bf(state_win[((size_t)c.b * 512 + k) * 256 + kv * 128 + c.g * 64 + d]));
    return bf2f((bf16_t)f2bf(F.out[O_WS + ((size_t)c.b * 512 + 504 + (k - 512)) * 256 + kv * 128 + c.g * 64 + d]));
}
__device__ __forceinline__ void check_item(Frame& F, int row, int g, LAS float* wl, gu32* ctl) {
    const int lane = F.lane;
    ChkCtx c; c.sample = row >= MP; c.g = g;
    if (c.sample) { const int rs = row - MP; c.b = rs >> 3; c.qpos = PAST + (rs & 7); } else { c.b = row >> 13; c.qpos = row & (SEQ - 1); }
    const int nc = c.sample ? 1023 : 511, ns = c.sample ? 257 : 128, cur = c.qpos >> 6;
    LAS float* sc = wl;
    LAS float* ps = wl + 1024;
    LAS float* iv = wl + 2048;
    LAS float* qv = wl + 2048 + 264;
    LAS int* sl = (LAS int*)(wl + 2048 + 264 + 256);
    for (int i = lane; i < 256; i += 64) qv[i] = bf2f(Q[(size_t)row * 512 + (g * 4 + (i >> 6)) * 64 + (i & 63)]) * (1.f / LOG2E);
    for (int i = lane; i < 1024; i += 64) ps[i] = 0.f;
    float oc[4], os[4], ow[4];
#pragma unroll
    for (int r = 0; r < 4; ++r) { const int head = g * 4 + r; float mx = -INFINITY;
        for (int i = lane; i < nc; i += 64) { const int cend = 16 * i + 31; float s = -INFINITY;
            if (cend <= c.qpos) { s = 0.f; for (int d = 0; d < 64; ++d) s += qv[r * 64 + d] * chk_cmp_kv(F, c, 0, i, d); s += rel_table[chk_bucket(c.qpos - cend) * 8 + head]; }
            sc[i] = s; mx = fmaxf(mx, s); }
        mx = wave_max(mx); float l = 0.f;
        for (int i = lane; i < nc; i += 64) { const float p = (sc[i] == -INFINITY) ? 0.f : expf(sc[i] - mx); sc[i] = p; l += p; }
        l = wave_sum(l); const float il = l > 0.f ? 1.f / l : 0.f;
        for (int i = lane; i < nc; i += 64) { sc[i] *= il; ps[i] += sc[i]; }
        float a = 0.f; for (int i = 0; i < nc; ++i) a += sc[i] * chk_cmp_kv(F, c, 1, i, lane);
        oc[r] = a; }
    for (int j = lane; j < ns; j += 64) { float a = 0.f; for (int i = 4 * j - 1; i <= 4 * j + 3; ++i) if (i >= 0 && i < nc) a += ps[i];
        const bool forced = (j == 0 || j == cur || j == cur - 1), valid = (64 * j <= c.qpos);
        iv[j] = valid ? a + (forced ? 1e6f : 0.f) : -1e30f; }
    for (int k = 0; k < 16; ++k) { float bv = -INFINITY; int bi = 1 << 30;
        for (int j = lane; j < ns; j += 64) { const float v = iv[j]; if (v > bv) { bv = v; bi = j; } }
        for (int o = 1; o < 64; o <<= 1) { const float ov = __shfl_xor(bv, o); const int oi = __shfl_xor(bi, o); if (ov > bv || (ov == bv && oi < bi)) { bv = ov; bi = oi; } }
        if (lane == 0) { sl[k] = (k < ns && bv > -5e29f) ? bi : -1; if (bi < ns) iv[bi] = -INFINITY; } }
#pragma unroll
    for (int r = 0; r < 4; ++r) { const int head = g * 4 + r; float mx = -INFINITY;
        for (int e = lane; e < 1024; e += 64) { const int blk = sl[e >> 6]; float s = -INFINITY;
            if (blk >= 0) { const int pos = blk * 64 + (e & 63); if (pos <= c.qpos) { s = 0.f; for (int d = 0; d < 64; ++d) s += qv[r * 64 + d] * chk_sel_kv(F, c, 0, pos, d); s += rel_table[chk_bucket(c.qpos - pos) * 8 + head]; } }
            sc[e] = s; mx = fmaxf(mx, s); }
        mx = wave_max(mx); float l = 0.f;
        for (int e = lane; e < 1024; e += 64) { const float p = (sc[e] == -INFINITY) ? 0.f : expf(sc[e] - mx); sc[e] = p; l += p; }
        l = wave_sum(l); const float il = l > 0.f ? 1.f / l : 0.f;
        float a = 0.f; for (int e = 0; e < 1024; ++e) { const float p = sc[e]; if (p != 0.f) a += p * chk_sel_kv(F, c, 1, sl[e >> 6] * 64 + (e & 63), lane); }
        os[r] = a * il; }
#pragma unroll
    for (int r = 0; r < 4; ++r) { const int head = g * 4 + r; float mx = -INFINITY;
        for (int e = lane; e < 512; e += 64) { const int pos = c.qpos - e; float s = -INFINITY;
            if (pos >= 0) { s = 0.f; for (int d = 0; d < 64; ++d) s += qv[r * 64 + d] * chk_win_kv(F, c, 0, pos, d); s += rel_table[chk_bucket(e) * 8 + head]; }
            sc[e] = s; mx = fmaxf(mx, s); }
        mx = wave_max(mx); float l = 0.f;
        for (int e = lane; e < 512; e += 64) { const float p = (sc[e] == -INFINITY) ? 0.f : expf(sc[e] - mx); sc[e] = p; l += p; }
        l = wave_sum(l); const float il = l > 0.f ? 1.f / l : 0.f;
        float a = 0.f; for (int e = 0; e < 512; ++e) { const float p = sc[e]; if (p != 0.f) a += p * chk_win_kv(F, c, 1, c.qpos - e, lane); }
        ow[r] = a * il; }
    bool bad = false;
#pragma unroll
    for (int r = 0; r < 4; ++r) { const int head = g * 4 + r; const float* gp = GATES + (size_t)row * 24 + head * 3;
        const float ref = gp[0] * oc[r] + gp[1] * os[r] + gp[2] * ow[r];
        const float got = WSP(float, WS_DBG)[(size_t)row * 512 + head * 64 + lane];
        const float e2 = wave_sum((ref - got) * (ref - got)), r2 = wave_sum(ref * ref);
        if (!(e2 <= CHECK_TOL * CHECK_TOL * r2)) bad = true; }
    if (lane == 0) { __hip_atomic_fetch_add(ctl + CW_NITEM, 1u, RLX_AGENT); if (bad) __hip_atomic_fetch_add(ctl + CW_NFAIL, 1u, RLX_AGENT); }
}
__device__ __forceinline__ void check_cmp_item(Frame& F, bool sample, int kv, int b, int g, int i, LAS float* wl, gu32* ctl) {
    const int lane = F.lane;
    LAS float* hv = wl;
    float hacc[4];
#pragma unroll
    for (int u = 0; u < 4; ++u) hacc[u] = cmp_b1[kv * 256 + 64 * u + lane];
    for (int k = 0; k < 2048; ++k) { const int l2 = k >> 6, d = k & 63, t = 16 * i + l2; float x;
        if (sample) { const int phys = page_table[b * NPAGES + (t >> 7)]; x = cache_cmp[((size_t)phys * PAGE + (t & 127)) * 256 + kv * 128 + g * 64 + d]; }
        else x = F.out[O_CP + ((size_t)b * SEQ + t) * 256 + kv * 128 + g * 64 + d];
        x += cmp_pe[kv * 2048 + k];
#pragma unroll
        for (int u = 0; u < 4; ++u) hacc[u] += x * cmp_w1[((size_t)kv * 2048 + k) * 256 + 64 * u + lane]; }
#pragma unroll
    for (int u = 0; u < 4; ++u) { const float x = hacc[u]; hv[64 * u + lane] = 0.5f * x * (1.f + tanhf(0.7978845608028654f * (x + 0.044715f * x * x * x))); }
    float o = cmp_b2[kv * 64 + lane];
    for (int hh = 0; hh < 256; ++hh) o += hv[hh] * cmp_w2[((size_t)kv * 256 + hh) * 64 + lane];
    const bf16_t* got = sample ? KCS + (size_t)kv * DB * 2 * NCS * 64 + ((size_t)(b * 2 + g) * NCS + i) * 64 : KC + (size_t)kv * NB * 2 * 512 * 64 + ((size_t)(b * 2 + g) * 512 + i) * 64;
    const float gv = bf2f(got[lane]);
    const float e2 = wave_sum((o - gv) * (o - gv)), r2 = wave_sum(o * o);
    if (lane == 0) { __hip_atomic_fetch_add(ctl + CW_NITEM, 1u, RLX_AGENT); if (!(e2 <= CHECK_TOL * CHECK_TOL * r2)) __hip_atomic_fetch_add(ctl + CW_NFAILC, 1u, RLX_AGENT); }
}
__device__ __forceinline__ void check_phase(Frame& F, gu32* ctl) {
    LAS float* wl = (LAS float*)(F.lds + F.wave * 16384);
    const int gw = F.gw;
    if (gw < 512 && CHECK_SUBSET != 2) {
        const int idx = gw >> 1, g = gw & 1;
        int pos, b;
        if (idx < 32) { pos = CHK_SPECIAL[idx]; b = idx & 3; } else { pos = (idx * 2654435761u) % SEQ; b = idx & 3; }
        check_item(F, b * SEQ + pos, g, wl, ctl);
    } else if (gw >= 512 && gw < 1024 && CHECK_SUBSET != 1) { const int k = gw - 512; check_item(F, MP + (k >> 1), k & 1, wl, ctl); }
    else if (gw >= 1024 && gw < 1024 + 128) { const int k = gw - 1024; const int i = (k < 8) ? (k < 4 ? k : 507 + (k - 4)) : (int)((k * 2654435761u) % 511u); check_cmp_item(F, false, k & 1, (k >> 1) & 3, (k >> 3) & 1, i, wl, ctl); }
    else if (gw >= 1152 && gw < 1024 + 256) { const int k = gw - 1152; const int i = (k < 8) ? (k < 4 ? k : 1019 + (k - 4)) : (int)((k * 2654435761u) % 1023u); check_cmp_item(F, true, k & 1, (k >> 1) & 31, (k >> 6) & 1, i, wl, ctl); }
}
#endif
__device__ __forceinline__ void attn_bias_table(Frame& F, LAS float* tb) {
    for (int i = F.tid; i < 129 * 8; i += 512) { const int d = i >> 3, hd = i & 7; const int bk = d < 128 ? T5_BUCKET[d] : 31; tb[i] = rel_table[bk * 8 + hd] * LOG2E; }
    __syncthreads();
    LAS f32x4* t2 = (LAS f32x4*)(F.lds + LDS_T2);
    for (int i = F.tid; i < 8 * T2N; i += 512) { const int hd = i / T2N, k = i % T2N, e = k - 1, x = k - 134; f32x4 v;
#pragma unroll
        for (int r = 0; r < 4; ++r) { const int d = e - r; v[r] = (k < 133) ? (d < 0 ? -INFINITY : tb[(d > 128 ? 128 : d) * 8 + hd]) : (x - r < 0 ? tb[128 * 8 + hd] : -INFINITY); }
        t2[i] = v; }
    __syncthreads();
}

constexpr int N_PHASES = 6;
__device__ __forceinline__ void sample_outproj_norm(Frame& F, gu32* ctl) {
    const int lane = F.lane, w = F.wave, j = lane & 15, h = lane >> 4;
    LAS f32x4* red = (LAS f32x4*)F.lds;
    LAS float* part = (LAS float*)(F.lds + 32768); LAS float* rsv = part + 64;
    const int t = blockIdx.x, rg = t >> 4, cg = t & 15, r0 = 16 * rg, n0 = 64 * cg;
    const bf16_t* ap = WoutT + (size_t)(n0 + j) * DM + 128 * w + 8 * h;
    const bf16_t* bp = MIXO + (size_t)(MP + r0 + j) * DM + 128 * w + 8 * h;
    bf16x8 bq[4];
#pragma unroll
    for (int ks = 0; ks < 4; ++ks) bq[ks] = *(const bf16x8*)(bp + 32 * ks);
    f32x4 acc[4];
#pragma unroll
    for (int nt = 0; nt < 4; ++nt) { acc[nt] = (f32x4){0.f, 0.f, 0.f, 0.f};
#pragma unroll
        for (int ks = 0; ks < 4; ++ks) acc[nt] = __builtin_amdgcn_mfma_f32_16x16x32_bf16(*(const bf16x8*)(ap + (size_t)nt * 16 * DM + 32 * ks), bq[ks], acc[nt], 0, 0, 0); }
#pragma unroll
    for (int nt = 0; nt < 4; ++nt) red[(w * 4 + nt) * 64 + lane] = acc[nt];
    __syncthreads();
    const size_t o = (size_t)(r0 + j) * DM + n0 + 16 * (w & 3) + 4 * h;
    f32x4 v = (f32x4){0.f, 0.f, 0.f, 0.f};
    if (w < 4) { f32x4 sm = red[w * 64 + lane];
#pragma unroll
        for (int ww = 1; ww < 8; ++ww) sm = sm + red[(ww * 4 + w) * 64 + lane];
        v = sm + *(const f32x4*)(x_sample + o);
        const float sq = xrow_sum((v[0] * v[0] + v[1] * v[1]) + (v[2] * v[2] + v[3] * v[3]));
        if (h == 0) part[w * 16 + j] = sq; }
    __syncthreads();
    if (w == 0) {
        unsigned* xs = (unsigned*)(F.ws + WS_XS2); gu32* cnt = ctl + CW_PANEL + 32 * (129 + rg);
        if (lane < 16) __hip_atomic_store(xs + (size_t)(r0 + lane) * 16 + cg, __float_as_uint((part[lane] + part[16 + lane]) + (part[32 + lane] + part[48 + lane])), RLX_AGENT);
        VM_WAIT();
        if (lane == 0) __hip_atomic_fetch_add(cnt, 1u, RLX_AGENT);
        bool dead = false; unsigned sp = 0;
        while ((unsigned)__builtin_amdgcn_readfirstlane((int)__hip_atomic_load(cnt, RLX_AGENT)) < 16u) { __builtin_amdgcn_s_sleep(2); if (++sp > (1u << 22)) { dead = true; break; } }
        if (dead && lane == 0) __hip_atomic_store(ctl + CW_BAR + XB_TMO, 1u, RLX_AGENT);
        __builtin_amdgcn_fence(__ATOMIC_ACQUIRE, "agent");
        if (lane < 16) { float ts = 0.f;
#pragma unroll
            for (int k = 0; k < 16; ++k) ts += __uint_as_float(__hip_atomic_load(xs + (size_t)(r0 + lane) * 16 + k, RLX_AGENT));
            float rs = 1.f / sqrtf(ts * (1.f / DM) + 1e-6f);
            if (dead) rs = __builtin_nanf("");
            rsv[lane] = rs; }
    }
    __syncthreads();
    if (w < 4) { const float rs = rsv[j]; const f32x4 g = *(const f32x4*)(final_g + n0 + 16 * w + 4 * h); *(f32x4*)(F.out + O_YS + o) = v * rs * g; }
    __syncthreads();
}

struct Args { const void* in[19]; float* out; unsigned char* ws; int ph_lo, ph_hi, li, pad; };

__global__ void __launch_bounds__(512, 2) fwd(Args args) {
    extern __shared__ __attribute__((aligned(16))) unsigned char lds[];
    Frame F;
    F.lds = (LAS unsigned char*)lds;
    volatile LAS unsigned* MISC = (volatile LAS unsigned*)(F.lds + LDS_MISC);
    F.tid = threadIdx.x; F.lane = F.tid & 63; F.wave = __builtin_amdgcn_readfirstlane(F.tid >> 6);
    F.G = gridDim.x; { const int bx = blockIdx.x; F.vcu = (F.G % 8 == 0) ? (bx % 8) * (F.G / 8) + bx / 8 : bx; }
    F.gw = F.vcu * 8 + F.wave; F.NGW = F.G * 8;
    F.ws = args.ws; F.out = args.out; F.in = args.in;
    gu32* ctl = (gu32*)(args.ws + WS_CTL);
    if (F.tid < 32) MISC[F.tid] = 0u;
    __syncthreads();
    XcdBarrier bar; bar.bar = (unsigned*)(ctl + CW_BAR) + args.li * XCD_BAR_WORDS; bar.x = 0; bar.st = nullptr;
    if (MK_N_LAUNCHES != N_PHASES) bar = xcd_barrier_post((unsigned*)(ctl + CW_BAR) + args.li * XCD_BAR_WORDS, MISC + 8);
#define GRID_BAR() do { if (MK_N_LAUNCHES != N_PHASES) xcd_barrier(bar); } while (0)
    const int lo = args.ph_lo, hi = args.ph_hi;
#ifndef PH_MASK
#define PH_MASK 0x3f
#endif
#define IN(k) (((PH_MASK >> (k)) & 1) && lo <= (k) && (k) < hi)
#define BOTH(k) (IN(k) && IN((k) + 1))
#define NREP(k) ((k) == REP_PHASE ? 2 : 1)

    if (IN(0)) { for (int rep = 0; rep < NREP(0); ++rep) p0_prologue(F); if (BOTH(0)) GRID_BAR(); }

    if (IN(1)) {
        {
            pg8::Gemm g{H, WinT, DM, DM}; pg8::StaticOrder S0; S0.init(MP, NPAD, F.G, (int)blockIdx.x);
            EpiInProj E{F.ws, F.out};
            const int k = (int)(blockIdx.x >> 3) & 7;
            { pg8::SubOrder<pg8::StaticOrder> S{S0, 0, k}; pg8::gemm_phase<EpiInProj, pg8::SubOrder<pg8::StaticOrder>>(F.lds, g, S, E); }
            convert_rows(F, (F.G - 1 - (int)blockIdx.x) & 255);
            asm volatile("s_waitcnt vmcnt(0)" ::: "memory"); __syncthreads();
            { pg8::SubOrder<pg8::StaticOrder> S{S0, k, 1 << 20}; pg8::gemm_phase<EpiInProj, pg8::SubOrder<pg8::StaticOrder>>(F.lds, g, S, E); }
        }
        for (int rep = 0; rep < NREP(2); ++rep) {
        { pg8::Gemm g{ACS, W1T, 1024, 2048}; pg8::KvOrder S; S.init(DB * 2 * NCS / 256, F.G, F.G - 1 - (int)blockIdx.x);
          EpiCmp<1> E{HCS, 256, HB, 256, 256};
          pg8::gemm_phase<EpiCmp<1>, pg8::KvOrder>(F.lds, g, S, E); }
        { pg8::Gemm g{HCS, W2T, 256, 256}; pg8::KvOrder S; S.init(DB * 2 * NCS / 256, F.G, F.G - 1 - (int)blockIdx.x);
          EpiCmp<0> E{KCS, 64, cmp_b2, 64, 64};
          pg8::gemm_phase<EpiCmp<0>, pg8::KvOrder>(F.lds, g, S, E); }
        }
        if (BOTH(1)) GRID_BAR();
    }

    if (IN(2)) {
        for (int rep = 0; rep < NREP(3); ++rep) {
        { pg8::Gemm g{AC, W1T, 1024, 2048}; pg8::KvOrder S; S.init(NB * 2 * 512 / 256, F.G, (int)blockIdx.x);
          EpiCmp<1> E{HC, 256, HB, 256, 256};
          pg8::gemm_phase<EpiCmp<1>, pg8::KvOrder>(F.lds, g, S, E); }
        { pg8::Gemm g{HC, W2T, 256, 256}; pg8::KvOrder S; S.init(NB * 2 * 512 / 256, F.G, (int)blockIdx.x);
          EpiCmp<0> E{KC, 64, cmp_b2, 64, 64};
          pg8::gemm_phase<EpiCmp<0>, pg8::KvOrder>(F.lds, g, S, E); }
        }
        { const int c = (int)blockIdx.x - 32;
          pg8::Gemm g{H, WinT, DM, DM}; pg8::OneUnit S{MP / 256, c, c >= 0 && c < NPAD / 256};
          EpiInProj E{F.ws, F.out};
          pg8::gemm_phase<EpiInProj, pg8::OneUnit>(F.lds, g, S, E); }
        __syncthreads();
        if (args.pad & 32) {} else
        if (F.G == 256) {
            const int rk = ((int)blockIdx.x - 46) * 8 + F.wave;
            if (rk >= 0) spatial_task(F, rk >> 3, rk & 7, (LAS char*)(F.lds + F.wave * SP_BYTES));
        } else
        for (int t = F.gw; t < (MP / 128) * 8; t += F.NGW) spatial_task(F, t >> 3, t & 7, (LAS char*)(F.lds + F.wave * SP_BYTES));
        if (BOTH(2)) GRID_BAR();
    }

    if (IN(3)) {
        for (int t = F.gw; t < DB * 8; t += F.NGW) spatial_sample_task(F, t >> 3, t & 7);
        attn_phase(F, ctl, args.pad, (F.G == 256) ? 46 : 0);
        if (BOTH(3)) GRID_BAR();
    }

#ifdef ATTN_CHECK
    if (IN(4)) { check_phase(F, ctl); __syncthreads(); }
#endif
    const bool fused_norm = (F.G == 256);
    if (IN(4)) {
        pg8::Gemm g{MIXO, WoutT, DM, DM}; pg8::StaticOrder S; S.init(MP, DM, F.G, (int)blockIdx.x);
        if (fused_norm) {
            sample_outproj_norm(F, ctl);
            EpiOutNorm E{x_prompt, final_g, F.out, (unsigned*)(F.ws + WS_XS), (unsigned*)(ctl + CW_PANEL), (unsigned*)(ctl + CW_BAR + XB_TMO), F.lds + RING_BYTES};
            pg8::gemm_phase<EpiOutNorm, pg8::StaticOrder>(F.lds, g, S, E);
        } else {
            EpiOut E{x_prompt, x_sample, F.out};
            pg8::gemm_phase<EpiOut, pg8::StaticOrder>(F.lds, g, S, E);
        }
#ifdef ATTN_CHECK
        if (BOTH(4)) GRID_BAR();
#else
        if (BOTH(4) && !fused_norm) GRID_BAR();
#endif
    }

    if (IN(5)) {
        const unsigned bad = __hip_atomic_load(ctl + CW_BAR + XB_TMO, RLX_AGENT);
        int m0, mstep, mend;
        if (fused_norm) { m0 = 0; mstep = 1; mend = 0; }
        else if (F.vcu < 4) {
            { pg8::Gemm g{MIXO, WoutT, DM, DM}; pg8::OneUnit S{MP / 256, F.vcu, true};
              EpiOut E{x_prompt, x_sample, F.out};
              pg8::gemm_phase<EpiOut, pg8::OneUnit>(F.lds, g, S, E); }
            if (F.tid == 0) {
                __builtin_amdgcn_fence(__ATOMIC_RELEASE, "agent");
                asm volatile("s_waitcnt vmcnt(0)" ::: "memory");
                __hip_atomic_fetch_add(ctl + CW_SOUT, 1u, RLX_AGENT);
                unsigned sp = 0;
                while (__hip_atomic_load(ctl + CW_SOUT, RLX_AGENT) < 4u) { __builtin_amdgcn_s_sleep(2); if (++sp > (1u << 22)) { __hip_atomic_store(ctl + CW_BAR + XB_TMO, 1u, RLX_AGENT); break; } }
                __builtin_amdgcn_fence(__ATOMIC_ACQUIRE, "agent");
                asm volatile("s_waitcnt vmcnt(0)" ::: "memory");
            }
            __syncthreads();
            m0 = MP + 64 * F.vcu + F.wave; mstep = 8; mend = MP + 64 * F.vcu + 64;
        } else { m0 = (F.vcu - 4) * 8 + F.wave; mstep = (F.G - 4) * 8; mend = MP; }
        const unsigned bad2 = bad | __hip_atomic_load(ctl + CW_BAR + XB_TMO, RLX_AGENT);
        for (int m = m0; m < mend; m += mstep) {
            float* yr = F.out + (size_t)m * DM;
            f32x4 v[4]; float s = 0.f;
#pragma unroll
            for (int j = 0; j < 4; ++j) { v[j] = *(const f32x4*)(yr + 256 * j + 4 * F.lane); s += (v[j][0] * v[j][0] + v[j][1] * v[j][1]) + (v[j][2] * v[j][2] + v[j][3] * v[j][3]); }
            float rs = 1.f / sqrtf(wave_sum(s) * (1.f / DM) + 1e-6f);
            if (bad2) rs = __builtin_nanf("");
#pragma unroll
            for (int j = 0; j < 4; ++j) { const f32x4 g = *(const f32x4*)(final_g + 256 * j + 4 * F.lane); *(f32x4*)(yr + 256 * j + 4 * F.lane) = v[j] * rs * g; }
        }
    }
#ifdef ATTN_CHECK
    if (IN(5) && blockIdx.x == 0 && F.tid == 0) {
        VM_WAIT();
        const unsigned nf = __hip_atomic_load(ctl + CW_NFAIL, RLX_AGENT), nfc = __hip_atomic_load(ctl + CW_NFAILC, RLX_AGENT), ni = __hip_atomic_load(ctl + CW_NITEM, RLX_AGENT);
        F.out[O_YS + 0] += 1000.f * (float)nf; F.out[O_YS + 1] += 100000.f * (float)nfc; if (ni != 1280u && CHECK_SUBSET == 0) F.out[O_YS + 2] += 1e7f;
    }
#endif
#undef IN
#undef BOTH
}

extern "C" void kernel_launch(void* const* d_in, const int* in_sizes, int n_in, void* d_out, int out_size, void* d_ws, size_t ws_size, hipStream_t stream) {
    static int grid = 0;
    if (grid == 0) {
        if (n_in != 19 || ws_size < WS_END) { fprintf(stderr, "kernel_launch: unexpected inputs (n_in %d, ws %zu)\n", n_in, ws_size); grid = -1; return; }
        int dev = 0, cus = 0;
        if (hipGetDevice(&dev) != hipSuccess || hipDeviceGetAttribute(&cus, hipDeviceAttributeMultiprocessorCount, dev) != hipSuccess) { grid = -1; return; }
        if (hipFuncSetAttribute((const void*)fwd, hipFuncAttributeMaxDynamicSharedMemorySize, LDS_BYTES) != hipSuccess) { fprintf(stderr, "kernel_launch: hipFuncSetAttribute failed\n"); grid = -1; return; }
        int per_cu = 0;
        if (hipOccupancyMaxActiveBlocksPerMultiprocessor(&per_cu, (const void*)fwd, 512, LDS_BYTES) != hipSuccess || per_cu < 1) fprintf(stderr, "kernel_launch: occupancy query says %d\n", per_cu);
        (void)hipGetLastError();
        grid = cus;
    }
    if (grid < 0) return;
    (void)hipMemsetAsync((char*)d_ws + WS_CTL, 0, CTL_ZERO_BYTES, stream);
    Args a{};
    for (int i = 0; i < 19; ++i) a.in[i] = d_in[i];
    a.out = (float*)d_out; a.ws = (unsigned char*)d_ws;
    if (MK_N_LAUNCHES == 1) { a.ph_lo = 0; a.ph_hi = N_PHASES; a.li = 0; hipLaunchKernelGGL(fwd, dim3(grid), dim3(512), LDS_BYTES, stream, a);
#if REP_PHASE >= 20 && REP_PHASE <= 24
        for (int rc = 0; rc < REP_COUNT; ++rc) {
        (void)hipMemsetAsync((char*)d_ws + WS_CTL, 0, CTL_ZERO_BYTES, stream);
        a.ph_lo = REP_PHASE - 20; a.ph_hi = (REP_PHASE == 24) ? 6 : REP_PHASE - 19; a.li = 0; a.pad = PROBE_VAR; hipLaunchKernelGGL(fwd, dim3(grid), dim3(512), LDS_BYTES, stream, a); }
#endif
#if REP_PHASE == 5 || REP_PHASE == 8 || REP_PHASE == 9
        if (REP_PHASE != 9) (void)hipMemsetAsync((char*)d_ws + WS_CTL + (size_t)CW_QHEAD * 4, 0, 8 * 256, stream);
        if (REP_PHASE != 8) (void)hipMemsetAsync((char*)d_ws + WS_CTL + (size_t)CW_QSAMP * 4, 0, 256, stream);
        a.ph_lo = 3; a.ph_hi = 4; a.li = 1; a.pad = PROBE_VAR; hipLaunchKernelGGL(fwd, dim3(grid), dim3(512), LDS_BYTES, stream, a);
#endif
    }
    else for (int li = 0; li < N_PHASES; ++li) { a.ph_lo = li; a.ph_hi = li + 1; a.li = 0; hipLaunchKernelGGL(fwd, dim3(grid), dim3(512), LDS_BYTES, stream, a); }
}
```
